# Optimizing an MI355X kernel written in HIP

```python
import math
import jax, jax.numpy as jnp
from jax import lax
import numpy as np

D_MODEL = 2048
BATCH = 8
SEQ = 2048
DEPTH = 1

HG_HEADS = 8
HG_DK = 128
HG_DV = 128
HG_WIDTH = HG_HEADS * HG_DK
HG_CHUNK = 64

AT_HEADS = 16
AT_KV_HEADS = 4
AT_HEAD_DIM = 64
AT_GROUP = AT_HEADS // AT_KV_HEADS
AT_WIDTH = AT_HEADS * AT_HEAD_DIM
KV_WIDTH = AT_KV_HEADS * AT_HEAD_DIM
WINDOW = 128
BLOCK = 128

N_BUCKETS = 32
MAX_EXACT = N_BUCKETS // 2
MAX_DISTANCE = 128

D_FF = 4 * D_MODEL
N_BRANCH = 2
EPS = 1e-6
NEG_INF = -1e30

IN_WIDTH = 4 * HG_WIDTH + AT_WIDTH + 2 * KV_WIDTH + N_BRANCH * D_MODEL
IN_OFFSETS = (
    HG_WIDTH,
    2 * HG_WIDTH,
    3 * HG_WIDTH,
    4 * HG_WIDTH,
    4 * HG_WIDTH + AT_WIDTH,
    4 * HG_WIDTH + AT_WIDTH + KV_WIDTH,
    4 * HG_WIDTH + AT_WIDTH + 2 * KV_WIDTH,
    4 * HG_WIDTH + AT_WIDTH + 2 * KV_WIDTH + D_MODEL,
)

kernel_name = "hgrn2_swa_sink_gated_hybrid_block"


def rms_norm(x, g):
    xf = x.astype(jnp.float32)
    y = xf * lax.rsqrt(jnp.mean(xf * xf, axis=-1, keepdims=True) + EPS)
    return (y * g.astype(jnp.float32)).astype(x.dtype)


def modulate(h, shift, scale):
    return h * (1.0 + scale[:, None, :]) + shift[:, None, :]


def t5_causal_bucket(n):
    nf = jnp.maximum(n, 1).astype(jnp.float32)
    large = MAX_EXACT + (jnp.log(nf / MAX_EXACT) / math.log(MAX_DISTANCE / MAX_EXACT)
                         * (N_BUCKETS - MAX_EXACT)).astype(jnp.int32)
    large = jnp.minimum(large, N_BUCKETS - 1)
    return jnp.where(n < MAX_EXACT, n, large)


def band_geometry(n_blocks):
    i = jnp.arange(BLOCK, dtype=jnp.int32)[:, None]
    j = jnp.arange(2 * BLOCK, dtype=jnp.int32)[None, :]
    dist = i - j + BLOCK
    blk = jnp.arange(n_blocks, dtype=jnp.int32)[:, None, None]
    key_pos = blk * BLOCK - BLOCK + j
    mask = (dist >= 0) & (dist < WINDOW) & (key_pos >= 0)
    bucket = t5_causal_bucket(jnp.maximum(dist, 0))
    return mask, bucket


def hgrn2_chunkwise(q, log_f, k, v):
    B, H, L, DK = q.shape
    DV = v.shape[-1]
    C = HG_CHUNK
    N = L // C
    q = q.reshape(B, H, N, C, DK)
    k = k.reshape(B, H, N, C, DK)
    v = v.reshape(B, H, N, C, DV)
    b = jnp.cumsum(log_f.reshape(B, H, N, C, DK), axis=3)
    ref = b[:, :, :, C // 2 - 1:C // 2]
    b_last = b[:, :, :, C - 1:]
    scores = jnp.einsum('bhncd,bhnsd->bhncs', q * jnp.exp(b - ref), k * jnp.exp(ref - b))
    causal = jnp.tril(jnp.ones((C, C), dtype=bool))
    scores = jnp.where(causal, scores, 0.0)
    o = jnp.einsum('bhncs,bhnsv->bhncv', scores, v)
    upd = jnp.einsum('bhncd,bhncv->bhndv', k * jnp.exp(b_last - b), v)
    decay = jnp.exp(b_last[:, :, :, 0])

    def step(S, xs):
        dec, u = xs
        return dec[..., None] * S + u, S

    _, S_prev = lax.scan(step, jnp.zeros((B, H, DK, DV), q.dtype),
                         (jnp.moveaxis(decay, 2, 0), jnp.moveaxis(upd, 2, 0)))
    S_prev = jnp.moveaxis(S_prev, 0, 2)
    o = o + jnp.einsum('bhncd,bhndv->bhncv', q * jnp.exp(b), S_prev)
    return o.reshape(B, H, L, DV)


def sink_swa(q, k, v, sinks, rel_bias_table):
    B, L = q.shape[0], q.shape[1]
    nb = L // BLOCK
    qb = q.reshape(B, nb, BLOCK, AT_KV_HEADS, AT_GROUP, AT_HEAD_DIM)

    def band(t):
        tb = t.reshape(B, nb, BLOCK, AT_KV_HEADS, AT_HEAD_DIM)
        prev = jnp.pad(tb, ((0, 0), (1, 0), (0, 0), (0, 0), (0, 0)))[:, :-1]
        return jnp.concatenate([prev, tb], axis=2)

    kk, vv = band(k), band(v)
    mask, bucket = band_geometry(nb)
    bias = jnp.transpose(rel_bias_table[bucket], (2, 0, 1)).astype(jnp.float32)
    bias = bias.reshape(AT_KV_HEADS, AT_GROUP, BLOCK, 2 * BLOCK)
    scale = AT_HEAD_DIM ** -0.5
    logits = jnp.einsum('bnqkgd,bnskd->bnkgqs', qb, kk).astype(jnp.float32) * scale + bias
    logits = jnp.where(mask[None, :, None, None], logits, NEG_INF)
    sink = jnp.broadcast_to(sinks.astype(jnp.float32).reshape(AT_KV_HEADS, AT_GROUP, 1, 1),
                            logits.shape[:-1] + (1,))
    p = jax.nn.softmax(jnp.concatenate([logits, sink], axis=-1), axis=-1)[..., :2 * BLOCK]
    o = jnp.einsum('bnkgqs,bnskd->bnqkgd', p.astype(vv.dtype), vv)
    return o.reshape(B, L, AT_WIDTH)


def setup_inputs(seed: int = 0) -> dict:
    key = jax.random.key(seed)
    ks = jax.random.split(key, 20)

    def nrm(k, shape, s):
        return jax.random.normal(k, shape, jnp.float32) * s

    return {
        "x": nrm(ks[0], (BATCH, SEQ, D_MODEL), 1.0),
        "c": nrm(ks[1], (BATCH, D_MODEL), 1.0),
        "w_ada": nrm(ks[2], (DEPTH, D_MODEL, 6 * D_MODEL), 0.5 * D_MODEL ** -0.5),
        "b_ada": nrm(ks[3], (DEPTH, 6 * D_MODEL), 0.02),
        "norm1_g": 1.0 + nrm(ks[4], (DEPTH, D_MODEL), 0.02),
        "norm2_g": 1.0 + nrm(ks[5], (DEPTH, D_MODEL), 0.02),
        "w_in": nrm(ks[6], (DEPTH, D_MODEL, IN_WIDTH), D_MODEL ** -0.5),
        "hg_lb_logits": nrm(ks[7], (DEPTH + 1, HG_WIDTH), 1.0),
        "hg_out_norm_g": 1.0 + nrm(ks[8], (DEPTH, HG_DV), 0.02),
        "q_norm_g": 1.0 + nrm(ks[9], (DEPTH, AT_HEAD_DIM), 0.02),
        "k_norm_g": 1.0 + nrm(ks[10], (DEPTH, AT_HEAD_DIM), 0.02),
        "attn_sinks": nrm(ks[11], (DEPTH, AT_HEADS), 1.0),
        "rel_bias_table": nrm(ks[12], (N_BUCKETS, AT_HEADS), 0.5),
        "w_branch_hg": nrm(ks[13], (DEPTH, HG_WIDTH, D_MODEL), HG_WIDTH ** -0.5),
        "w_branch_attn": nrm(ks[14], (DEPTH, AT_WIDTH, D_MODEL), AT_WIDTH ** -0.5),
        "w_out": nrm(ks[15], (DEPTH, D_MODEL, D_MODEL), D_MODEL ** -0.5),
        "w_ff1": nrm(ks[16], (DEPTH, D_MODEL, D_FF), D_MODEL ** -0.5),
        "w_ff2": nrm(ks[17], (DEPTH, D_FF, D_MODEL), D_FF ** -0.5),
    }


def reference(x, c, w_ada, b_ada, norm1_g, norm2_g, w_in, hg_lb_logits, hg_out_norm_g,
              q_norm_g, k_norm_g, attn_sinks, rel_bias_table, w_branch_hg, w_branch_attn,
              w_out, w_ff1, w_ff2):
    B, L, _ = x.shape
    lb_all = jnp.cumsum(jax.nn.softmax(hg_lb_logits.astype(jnp.float32), axis=0), axis=0)
    c_act = jax.nn.silu(c)
    for l in range(DEPTH):
        ada = c_act @ w_ada[l] + b_ada[l]
        shift1, scale1, gate1, shift2, scale2, gate2 = jnp.split(ada, 6, axis=-1)

        h = modulate(rms_norm(x, norm1_g[l]), shift1, scale1)
        proj = h @ w_in[l]
        hq, hf, hi, hg, aq, ak, av, gate_hg, gate_at = jnp.split(proj, IN_OFFSETS, axis=-1)

        lb = lb_all[l]
        f = lb + (1.0 - lb) * jax.nn.sigmoid(hf.astype(jnp.float32))
        log_f = jnp.log(f)

        def to_heads(t):
            return t.reshape(B, L, HG_HEADS, HG_DK).transpose(0, 2, 1, 3)

        o_hg = hgrn2_chunkwise(to_heads(jax.nn.silu(hq.astype(jnp.float32))), to_heads(log_f),
                               to_heads(1.0 - f), to_heads(hi.astype(jnp.float32)))
        o_hg = o_hg.transpose(0, 2, 1, 3).astype(x.dtype)
        o_hg = rms_norm(o_hg, hg_out_norm_g[l]) * jax.nn.silu(hg.reshape(B, L, HG_HEADS, HG_DV))
        o_hg = o_hg.reshape(B, L, HG_WIDTH)

        q = rms_norm(aq.reshape(B, L, AT_HEADS, AT_HEAD_DIM), q_norm_g[l])
        k = rms_norm(ak.reshape(B, L, AT_KV_HEADS, AT_HEAD_DIM), k_norm_g[l])
        v = av.reshape(B, L, AT_KV_HEADS, AT_HEAD_DIM)
        o_at = sink_swa(q, k, v, attn_sinks[l], rel_bias_table)

        merged = (jax.nn.sigmoid(gate_hg) * (o_hg @ w_branch_hg[l])
                  + jax.nn.sigmoid(gate_at) * (o_at @ w_branch_attn[l]))
        x = x + gate1[:, None, :] * (merged @ w_out[l])

        h2 = modulate(rms_norm(x, norm2_g[l]), shift2, scale2)
        ff = jnp.square(jax.nn.relu(h2 @ w_ff1[l])) @ w_ff2[l]
        x = x + gate2[:, None, :] * ff
    return x
```

```cpp
#include <hip/hip_runtime.h>
#include <type_traits>
#include <cstdio>
#include <cstdint>

#ifndef GEMM_SP2
#define GEMM_SP2 true
#endif
#ifndef GEMM_ALIGN
#define GEMM_ALIGN true
#endif
#ifndef P2_WGM
#define P2_WGM 4
#endif
#ifndef P8_WGM
#define P8_WGM 8
#endif
#ifndef P56_WGM
#define P56_WGM 4
#endif
#ifndef P9_WGM
#define P9_WGM 4
#endif
#ifndef MK_N_LAUNCHES
#define MK_N_LAUNCHES 1
#endif

namespace lay {
constexpr size_t MiB = 1u << 20, AR = 48 * MiB, DR = 16 * MiB;
constexpr size_t X1 = AR - 1 * MiB, X2 = AR - 2 * MiB, X4 = AR - 4 * MiB, X8 = AR - 8 * MiB, X32 = AR - 32 * MiB, XB = AR - 16384;
constexpr size_t D4 = DR - 4 * MiB, D8 = DR - 8 * MiB;
template <class T> __device__ __forceinline__ T* boff(T* p, size_t bytes) { return (T*)((char*)p + bytes); }
template <class T> __device__ __forceinline__ const T* boff(const T* p, size_t bytes) { return (const T*)((const char*)p + bytes); }
}
namespace pg8 {
#define PG8_LAS __attribute__((address_space(3)))
typedef unsigned short bf16_t;
typedef short bf16x8 __attribute__((ext_vector_type(8)));
typedef float f32x4 __attribute__((ext_vector_type(4)));
typedef unsigned u32x4 __attribute__((ext_vector_type(4)));
typedef float f32x2 __attribute__((ext_vector_type(2)));
typedef __bf16 bf16x2_t __attribute__((ext_vector_type(2)));
constexpr int BM = 256, BK = 64, HALF = 128, HTB = HALF * BK * 2, STAGE_BYTES = 8 * HTB, NXCD = 8;

__host__ __device__ __forceinline__ int lds_byte(int r, int c) { const int st = (r >> 4) * 2 + (c >> 5), rr = r & 15, cc = c & 31, ob = rr * 64 + cc * 2; return st * 1024 + (ob ^ (((ob >> 9) & 1) << 5)); }
__host__ __device__ __forceinline__ void stage_rc(int b, int& R, int& C) { const int st = b / 1024, sb = b % 1024, swz = sb ^ (((sb >> 9) & 1) << 5); R = (st >> 1) * 16 + swz / 64; C = (st & 1) * 32 + (swz % 64) / 2; }
__host__ __device__ __forceinline__ int perm32(int rho) { const int n = rho >> 4, i = rho & 15; return 8 * (i >> 2) + 4 * n + (i & 3); }

__device__ __forceinline__ size_t blk_off(int row, int col, int nkt) { return ((size_t)(row >> 7) * nkt + (col >> 6)) * 16384 + lds_byte(row & 127, col & 63); }
struct Unit { int pm, pn, seg; };
struct Gemm { const bf16_t *A0, *A1, *B0, *B1; int K; size_t xa0, xa1;
    __device__ __forceinline__ const char* a(int seg, int pm) const { return (const char*)(seg ? A1 : A0) + (size_t)(pm >> 3) * (seg ? xa1 : xa0); }
    __device__ __forceinline__ const char* b(int seg) const { return (const char*)(seg ? B1 : B0); }
    __device__ __forceinline__ int nt(int) const { return K / BK; } };
struct Gemm4 { const bf16_t *Ag, *A2, *A3, *Bg0, *Bg1, *B2, *B3; int Kg, Kb; size_t xag, xa2, xa3;
    __device__ __forceinline__ const char* a(int seg, int pm) const { return (const char*)(seg < 2 ? Ag : (seg == 2 ? A2 : A3)) + (size_t)(pm >> 3) * (seg < 2 ? xag : (seg == 2 ? xa2 : xa3)); }
    __device__ __forceinline__ const char* b(int seg) const { return (const char*)(seg == 0 ? Bg0 : (seg == 1 ? Bg1 : (seg == 2 ? B2 : B3))); }
    __device__ __forceinline__ int nt(int seg) const { return (seg < 2 ? Kg : Kb) / BK; } };

struct StaticOrder {
    int nM, nN, nwg, G, c, WGM;
    __device__ void init(int M, int N, int G_, int c_, int wgm = 8) { nM = M / BM; nN = N / BM; nwg = nM * nN; G = G_; c = c_; WGM = wgm; }
    __device__ bool tile(int i, Unit& u) const {
        const long L = (long)i * G + c; if (L >= nwg) return false;
        int wgid = (int)L; { const int q = nwg / NXCD, r = nwg % NXCD, xcd = wgid % NXCD, off = wgid / NXCD; wgid = (xcd < r ? xcd * (q + 1) : r * (q + 1) + (xcd - r) * q) + off; }
        const int nig = WGM * nN, gid = wgid / nig, fm = gid * WGM, gsz = (nM - fm) < WGM ? (nM - fm) : WGM;
        u.pm = fm + ((wgid % nig) % gsz); u.pn = (wgid % nig) / gsz; return true;
    }
    static constexpr int NSEG = 1;
    __device__ bool tl(int i, Unit& u) const { return tile(i, u); }
};
struct DualOrder {
    StaticOrder b;
    static constexpr int NSEG = 2;
    __device__ bool tl(int i, Unit& u) const { return b.tile(i, u); }
};
struct QuadOrder {
    StaticOrder b;
    static constexpr int NSEG = 4;
    __device__ bool tl(int i, Unit& u) const { return b.tile(i, u); }
};

__device__ __forceinline__ unsigned cvtpk(float lo, float hi) { f32x2 v = {lo, hi}; bf16x2_t b = __builtin_convertvector(v, bf16x2_t); return __builtin_bit_cast(unsigned, b); }
__device__ __forceinline__ float bflo(unsigned w) { return __uint_as_float(w << 16); }
__device__ __forceinline__ float bfhi(unsigned w) { return __uint_as_float(w & 0xffff0000u); }
__device__ __forceinline__ float fast_exp(float x) { return __builtin_amdgcn_exp2f(x * 1.4426950408889634f); }
__device__ __forceinline__ float sigmoidf_(float x) { return __builtin_amdgcn_rcpf(1.0f + fast_exp(-x)); }


struct EpiProj {
    static constexpr bool PERM = true;
    bf16_t *QH, *VH, *GH, *AQ, *AK, *VT, *GHG, *GAT; float* LOGF; const float* lb;
    __device__ __forceinline__ bool operator()(const f32x4 (&acc)[2][2][4][2], const Unit& u, int wr, int wc, int fr, int fq) const {
        const int pn = u.pn; const int row0 = u.pm * BM + wr * 64 + fr; const int cin = wc * 32 + 8 * fq;
        const size_t bb = (size_t)(u.pm >> 3);
        int mode, ldc, colt; bf16_t* base;
        if (pn < 4) { mode = 1; base = lay::boff(QH, bb * lay::X4); ldc = 1024; colt = pn * 256; }
        else if (pn < 8) { mode = 3; base = nullptr; ldc = 1024; colt = (pn - 4) * 256; }
        else if (pn < 12) { mode = 0; base = lay::boff(VH, bb * lay::X4); ldc = 1024; colt = (pn - 8) * 256; }
        else if (pn < 16) { mode = 1; base = lay::boff(GH, bb * lay::X4); ldc = 1024; colt = (pn - 12) * 256; }
        else if (pn < 20) { mode = 0; base = lay::boff(AQ, bb * lay::X4); ldc = 1024; colt = (pn - 16) * 256; }
        else if (pn == 20) { mode = 0; base = lay::boff(AK, bb * lay::X1); ldc = 256; colt = 0; }
        else if (pn == 21) { mode = 4; base = lay::boff(VT, bb * lay::X1); ldc = 0; colt = 0; }
        else if (pn < 30) { mode = 2; base = lay::boff(GHG, bb * lay::X8); ldc = 2048; colt = (pn - 22) * 256; }
        else { mode = 2; base = lay::boff(GAT, bb * lay::X8); ldc = 2048; colt = (pn - 30) * 256; }
        const int col0 = colt + cin;
        if (mode == 3) {
            f32x4 l0[2], l1[2];
#pragma unroll
            for (int bj = 0; bj < 2; ++bj) { l0[bj] = *(const f32x4*)(lb + col0 + bj * HALF); l1[bj] = *(const f32x4*)(lb + col0 + bj * HALF + 4); }
#pragma unroll
            for (int ai = 0; ai < 2; ++ai)
#pragma unroll
                for (int m = 0; m < 4; ++m) { float* rowp = lay::boff(LOGF, bb * lay::X8) + (size_t)(row0 + ai * HALF + m * 16) * 1024 + col0;
#pragma unroll
                    for (int bj = 0; bj < 2; ++bj) { const f32x4 v0 = acc[ai][bj][m][0], v1 = acc[ai][bj][m][1]; f32x4 o0, o1;
#pragma unroll
                        for (int e = 0; e < 4; ++e) { const float s0 = sigmoidf_(v0[e]), s1 = sigmoidf_(v1[e]);
                            o0[e] = __logf(l0[bj][e] + (1.0f - l0[bj][e]) * s0); o1[e] = __logf(l1[bj][e] + (1.0f - l1[bj][e]) * s1); }
                        *(f32x4*)(rowp + bj * HALF) = o0; *(f32x4*)(rowp + bj * HALF + 4) = o1; } }
            return false;
        }
        if (mode == 4) {
#pragma unroll
            for (int ai = 0; ai < 2; ++ai)
#pragma unroll
                for (int m = 0; m < 4; ++m) { const int row = row0 + ai * HALF + m * 16; const int b = row >> 11, t = row & 2047;
#pragma unroll
                    for (int bj = 0; bj < 2; ++bj) { const f32x4 v0 = acc[ai][bj][m][0], v1 = acc[ai][bj][m][1]; const int c = col0 + bj * HALF;
                        bf16_t* p = base + ((size_t)(b * 256 + c)) * 2048 + t;
                        const unsigned w0 = cvtpk(v0[0], v0[1]), w1 = cvtpk(v0[2], v0[3]), w2 = cvtpk(v1[0], v1[1]), w3 = cvtpk(v1[2], v1[3]);
                        p[0] = (bf16_t)w0; p[2048] = (bf16_t)(w0 >> 16); p[2 * 2048] = (bf16_t)w1; p[3 * 2048] = (bf16_t)(w1 >> 16);
                        p[4 * 2048] = (bf16_t)w2; p[5 * 2048] = (bf16_t)(w2 >> 16); p[6 * 2048] = (bf16_t)w3; p[7 * 2048] = (bf16_t)(w3 >> 16); } }
            return false;
        }
#pragma unroll
        for (int ai = 0; ai < 2; ++ai)
#pragma unroll
            for (int m = 0; m < 4; ++m) { bf16_t* rowp = base + (size_t)(row0 + ai * HALF + m * 16) * ldc + col0;
#pragma unroll
                for (int bj = 0; bj < 2; ++bj) { f32x4 v0 = acc[ai][bj][m][0], v1 = acc[ai][bj][m][1];
                    if (mode != 0) {
#pragma unroll
                        for (int e = 0; e < 4; ++e) { const float s0 = sigmoidf_(v0[e]), s1 = sigmoidf_(v1[e]); v0[e] = (mode == 1) ? v0[e] * s0 : s0; v1[e] = (mode == 1) ? v1[e] * s1 : s1; } }
                    u32x4 w; w.x = cvtpk(v0[0], v0[1]); w.y = cvtpk(v0[2], v0[3]); w.z = cvtpk(v1[0], v1[1]); w.w = cvtpk(v1[2], v1[3]);
                    *(u32x4*)(rowp + bj * HALF) = w; } }
        return false;
    }
};

struct EpiMerge {
    static constexpr bool PERM = true;
    const bf16_t *GHG, *GAT; bf16_t* OUT;
    __device__ __forceinline__ bool operator()(f32x4 (&acc)[2][2][4][2], const Unit& u, int wr, int wc, int fr, int fq) const {
        const int row0 = u.pm * BM + wr * 64 + fr, col0 = u.pn * BM + wc * 32 + 8 * fq;
        const bf16_t* GHG = lay::boff(this->GHG, (size_t)(u.pm >> 3) * lay::X8); const bf16_t* GAT = lay::boff(this->GAT, (size_t)(u.pm >> 3) * lay::X8); bf16_t* OUT = lay::boff(this->OUT, (size_t)(u.pm >> 3) * lay::X8);
        if (u.seg == 0) {
#pragma unroll
            for (int ai = 0; ai < 2; ++ai)
#pragma unroll
                for (int m = 0; m < 4; ++m) { const size_t off = (size_t)(row0 + ai * HALF + m * 16) * 2048 + col0;
#pragma unroll
                    for (int bj = 0; bj < 2; ++bj) {
                        const u32x4 ga = *(const u32x4*)(GAT + off + bj * HALF); const u32x4 gh = *(const u32x4*)(GHG + off + bj * HALF);
                        f32x4 r0, r1;
                        r0[0] = bflo(gh.x) * __builtin_amdgcn_rcpf(bflo(ga.x)); r0[1] = bfhi(gh.x) * __builtin_amdgcn_rcpf(bfhi(ga.x));
                        r0[2] = bflo(gh.y) * __builtin_amdgcn_rcpf(bflo(ga.y)); r0[3] = bfhi(gh.y) * __builtin_amdgcn_rcpf(bfhi(ga.y));
                        r1[0] = bflo(gh.z) * __builtin_amdgcn_rcpf(bflo(ga.z)); r1[1] = bfhi(gh.z) * __builtin_amdgcn_rcpf(bfhi(ga.z));
                        r1[2] = bflo(gh.w) * __builtin_amdgcn_rcpf(bflo(ga.w)); r1[3] = bfhi(gh.w) * __builtin_amdgcn_rcpf(bfhi(ga.w));
                        acc[ai][bj][m][0] *= r0; acc[ai][bj][m][1] *= r1; } }
            return true;
        }
#pragma unroll
        for (int ai = 0; ai < 2; ++ai)
#pragma unroll
            for (int m = 0; m < 4; ++m) { const size_t off = (size_t)(row0 + ai * HALF + m * 16) * 2048 + col0;
#pragma unroll
                for (int bj = 0; bj < 2; ++bj) {
                    const u32x4 ga = *(const u32x4*)(GAT + off + bj * HALF);
                    const f32x4 v0 = acc[ai][bj][m][0], v1 = acc[ai][bj][m][1];
                    u32x4 w; w.x = cvtpk(v0[0] * bflo(ga.x), v0[1] * bfhi(ga.x)); w.y = cvtpk(v0[2] * bflo(ga.y), v0[3] * bfhi(ga.y));
                    w.z = cvtpk(v1[0] * bflo(ga.z), v1[1] * bfhi(ga.z)); w.w = cvtpk(v1[2] * bflo(ga.w), v1[3] * bfhi(ga.w));
                    *(u32x4*)((char*)OUT + blk_off(row0 + ai * HALF + m * 16, col0 + bj * HALF, 2048 / 64)) = w; } }
        return false;
    }
};

struct EpiResGate {
    static constexpr bool PERM = true;
    const float* base; const bf16_t* delta; float* out; const float* gate; int gstride;
    __device__ __forceinline__ bool operator()(const f32x4 (&acc)[2][2][4][2], const Unit& u, int wr, int wc, int fr, int fq) const {
        const int row0 = u.pm * BM + wr * 64 + fr, col0 = u.pn * BM + wc * 32 + 8 * fq;
        const float* gp = gate + (size_t)(row0 >> 11) * gstride + col0;
        const bf16_t* delta = lay::boff(this->delta, (size_t)(u.pm >> 3) * lay::X8);
        f32x4 g0[2], g1[2];
#pragma unroll
        for (int bj = 0; bj < 2; ++bj) { g0[bj] = *(const f32x4*)(gp + bj * HALF); g1[bj] = *(const f32x4*)(gp + bj * HALF + 4); }
#ifndef EPI9_PF
#define EPI9_PF 1
#endif
        f32x4 xb0[2][2][2], xb1[2][2][2]; u32x4 xd[2][2][2];
        auto ld = [&](int k, int s) __attribute__((always_inline)) {
#pragma unroll
            for (int mm = 0; mm < 2; ++mm) { const size_t off = (size_t)(row0 + (k >> 1) * HALF + ((k & 1) * 2 + mm) * 16) * 2048 + col0;
#pragma unroll
                for (int bj = 0; bj < 2; ++bj) { xb0[s][mm][bj] = __builtin_nontemporal_load((const f32x4*)(base + off + bj * HALF)); xb1[s][mm][bj] = __builtin_nontemporal_load((const f32x4*)(base + off + bj * HALF + 4));
                    xd[s][mm][bj] = *(const u32x4*)(delta + off + bj * HALF); } } };
        auto cs = [&](int k, int s) __attribute__((always_inline)) {
#pragma unroll
            for (int mm = 0; mm < 2; ++mm) { const int ai = k >> 1, m = (k & 1) * 2 + mm; const size_t off = (size_t)(row0 + ai * HALF + m * 16) * 2048 + col0;
#pragma unroll
                for (int bj = 0; bj < 2; ++bj) { const u32x4 dv = xd[s][mm][bj];
                    const f32x4 d0 = (f32x4){bflo(dv.x), bfhi(dv.x), bflo(dv.y), bfhi(dv.y)}, d1 = (f32x4){bflo(dv.z), bfhi(dv.z), bflo(dv.w), bfhi(dv.w)};
                    *(f32x4*)(out + off + bj * HALF) = (xb0[s][mm][bj] + d0) + g0[bj] * acc[ai][bj][m][0]; *(f32x4*)(out + off + bj * HALF + 4) = (xb1[s][mm][bj] + d1) + g1[bj] * acc[ai][bj][m][1]; } } };
#define SB9 __builtin_amdgcn_sched_barrier(0)
        if (EPI9_PF == 0) { ld(0, 0); SB9; cs(0, 0); SB9; ld(1, 0); SB9; cs(1, 0); SB9; ld(2, 0); SB9; cs(2, 0); SB9; ld(3, 0); SB9; cs(3, 0); SB9; }
        else {
            ld(0, 0); SB9; cs(0, 0); SB9; ld(1, 1); ld(2, 0); SB9; cs(1, 1); SB9; ld(3, 1); SB9; cs(2, 0); SB9; cs(3, 1); SB9; }
#undef SB9
        return false;
    }
};

struct EpiMerge4 {
    static constexpr bool PERM = true;
    bf16_t* SCR; bf16_t* OUT;
    __device__ __forceinline__ bool operator()(f32x4 (&acc)[2][2][4][2], const Unit& u, int wr, int wc, int fr, int fq) const {
        const int row0 = u.pm * BM + wr * 64 + fr, col0 = u.pn * BM + wc * 32 + 8 * fq;
        unsigned zo = 0; asm volatile("" : "+v"(zo));
        u32x4* sc = (u32x4*)((char*)SCR + zo) + (wr * 4 + wc) * 64 + fq * 16 + fr;
        if (u.seg < 2) {
            u32x4* dst = sc + u.seg * 8192;
#pragma unroll
            for (int ai = 0; ai < 2; ++ai)
#pragma unroll
                for (int m = 0; m < 4; ++m)
#pragma unroll
                    for (int bj = 0; bj < 2; ++bj) { f32x4 v0 = acc[ai][bj][m][0], v1 = acc[ai][bj][m][1];
#pragma unroll
                        for (int e = 0; e < 4; ++e) { v0[e] = sigmoidf_(v0[e]); v1[e] = sigmoidf_(v1[e]); }
                        u32x4 w; w.x = cvtpk(v0[0], v0[1]); w.y = cvtpk(v0[2], v0[3]); w.z = cvtpk(v1[0], v1[1]); w.w = cvtpk(v1[2], v1[3]);
                        dst[((ai * 4 + m) * 2 + bj) * 512] = w; }
            return false;
        }
        if (u.seg == 2) {
#pragma unroll
            for (int ai = 0; ai < 2; ++ai) {
                u32x4 gh[4][2], ga[4][2];
#pragma unroll
                for (int m = 0; m < 4; ++m)
#pragma unroll
                    for (int bj = 0; bj < 2; ++bj) { const int pc = ((ai * 4 + m) * 2 + bj) * 512; gh[m][bj] = sc[pc]; ga[m][bj] = sc[8192 + pc]; }
#pragma unroll
                for (int m = 0; m < 4; ++m)
#pragma unroll
                    for (int bj = 0; bj < 2; ++bj) { const u32x4 h = gh[m][bj], a = ga[m][bj];
                        f32x4 r0, r1;
                        r0[0] = bflo(h.x) * __builtin_amdgcn_rcpf(bflo(a.x)); r0[1] = bfhi(h.x) * __builtin_amdgcn_rcpf(bfhi(a.x));
                        r0[2] = bflo(h.y) * __builtin_amdgcn_rcpf(bflo(a.y)); r0[3] = bfhi(h.y) * __builtin_amdgcn_rcpf(bfhi(a.y));
                        r1[0] = bflo(h.z) * __builtin_amdgcn_rcpf(bflo(a.z)); r1[1] = bfhi(h.z) * __builtin_amdgcn_rcpf(bfhi(a.z));
                        r1[2] = bflo(h.w) * __builtin_amdgcn_rcpf(bflo(a.w)); r1[3] = bfhi(h.w) * __builtin_amdgcn_rcpf(bfhi(a.w));
                        acc[ai][bj][m][0] *= r0; acc[ai][bj][m][1] *= r1; }
                asm volatile("" : "+v"(acc[ai][0][0][0]), "+v"(acc[ai][0][0][1]), "+v"(acc[ai][0][1][0]), "+v"(acc[ai][0][1][1]), "+v"(acc[ai][0][2][0]), "+v"(acc[ai][0][2][1]), "+v"(acc[ai][0][3][0]), "+v"(acc[ai][0][3][1]),
                                  "+v"(acc[ai][1][0][0]), "+v"(acc[ai][1][0][1]), "+v"(acc[ai][1][1][0]), "+v"(acc[ai][1][1][1]), "+v"(acc[ai][1][2][0]), "+v"(acc[ai][1][2][1]), "+v"(acc[ai][1][3][0]), "+v"(acc[ai][1][3][1]) :: "memory");
            }
            return true;
        }
        char* outb = (char*)OUT + (size_t)(u.pm >> 3) * lay::X8;
        u32x4 gav[2][4][2];
#pragma unroll
        for (int ai = 0; ai < 2; ++ai)
#pragma unroll
            for (int m = 0; m < 4; ++m)
#pragma unroll
                for (int bj = 0; bj < 2; ++bj) gav[ai][m][bj] = sc[8192 + ((ai * 4 + m) * 2 + bj) * 512];
        __builtin_amdgcn_sched_barrier(0);
#pragma unroll
        for (int ai = 0; ai < 2; ++ai)
#pragma unroll
            for (int m = 0; m < 4; ++m)
#pragma unroll
                for (int bj = 0; bj < 2; ++bj) { const u32x4 ga = gav[ai][m][bj];
                    const f32x4 v0 = acc[ai][bj][m][0], v1 = acc[ai][bj][m][1];
                    u32x4 w; w.x = cvtpk(v0[0] * bflo(ga.x), v0[1] * bfhi(ga.x)); w.y = cvtpk(v0[2] * bflo(ga.y), v0[3] * bfhi(ga.y));
                    w.z = cvtpk(v1[0] * bflo(ga.z), v1[1] * bfhi(ga.z)); w.w = cvtpk(v1[2] * bflo(ga.w), v1[3] * bfhi(ga.w));
                    *(u32x4*)(outb + blk_off(row0 + ai * HALF + m * 16, col0 + bj * HALF, 2048 / 64)) = w; }
        __builtin_amdgcn_sched_barrier(0);
        return false;
    }
};

struct EpiDelta {
    static constexpr bool PERM = true;
    bf16_t* O; const float* gate; int gstride;
    __device__ __forceinline__ bool operator()(const f32x4 (&acc)[2][2][4][2], const Unit& u, int wr, int wc, int fr, int fq) const {
        const int row0 = u.pm * BM + wr * 64 + fr, col0 = u.pn * BM + wc * 32 + 8 * fq;
        const float* gp = gate + (size_t)(row0 >> 11) * gstride + col0;
        f32x4 g0[2], g1[2];
#pragma unroll
        for (int bj = 0; bj < 2; ++bj) { g0[bj] = *(const f32x4*)(gp + bj * HALF); g1[bj] = *(const f32x4*)(gp + bj * HALF + 4); }
#pragma unroll
        for (int ai = 0; ai < 2; ++ai)
#pragma unroll
            for (int m = 0; m < 4; ++m) { bf16_t* rowp = lay::boff(O, (size_t)(u.pm >> 3) * lay::X8) + (size_t)(row0 + ai * HALF + m * 16) * 2048 + col0;
#pragma unroll
                for (int bj = 0; bj < 2; ++bj) { const f32x4 v0 = acc[ai][bj][m][0] * g0[bj], v1 = acc[ai][bj][m][1] * g1[bj];
                    u32x4 w; w.x = cvtpk(v0[0], v0[1]); w.y = cvtpk(v0[2], v0[3]); w.z = cvtpk(v1[0], v1[1]); w.w = cvtpk(v1[2], v1[3]);
                    *(u32x4*)(rowp + bj * HALF) = w; } }
        return false;
    }
};

struct EpiRelu2 {
    static constexpr bool PERM = true;
    bf16_t* O; int ldc;
    __device__ __forceinline__ bool operator()(const f32x4 (&acc)[2][2][4][2], const Unit& u, int wr, int wc, int fr, int fq) const {
        const int row0 = u.pm * BM + wr * 64 + fr, col0 = u.pn * BM + wc * 32 + 8 * fq;
#pragma unroll
        for (int ai = 0; ai < 2; ++ai)
#pragma unroll
            for (int m = 0; m < 4; ++m) { const int row = row0 + ai * HALF + m * 16;
#pragma unroll
                for (int bj = 0; bj < 2; ++bj) { f32x4 v0 = acc[ai][bj][m][0], v1 = acc[ai][bj][m][1];
#pragma unroll
                    for (int e = 0; e < 4; ++e) { const float r0 = fmaxf(v0[e], 0.f), r1 = fmaxf(v1[e], 0.f); v0[e] = r0 * r0; v1[e] = r1 * r1; }
                    u32x4 w; w.x = cvtpk(v0[0], v0[1]); w.y = cvtpk(v0[2], v0[3]); w.z = cvtpk(v1[0], v1[1]); w.w = cvtpk(v1[2], v1[3]);
                    __builtin_nontemporal_store(w, (u32x4*)((char*)O + (size_t)(u.pm >> 3) * lay::X32 + blk_off(row, col0 + bj * HALF, ldc / 64))); } }
        return false;
    }
};

struct NoHook { __device__ __forceinline__ void operator()() const {} };
template <class Epi, class Sched, bool ALIGN_EPI = false, bool SP2 = false, bool BLKB = true, bool BLKA = true, class GemmT = Gemm, class Hook = NoHook>
__device__ __forceinline__ void gemm_phase(PG8_LAS unsigned char* lds, const GemmT g, const Sched& S, const Epi& E, const Hook hook = Hook()) {
    const int tid = threadIdx.x, wid = __builtin_amdgcn_readfirstlane(tid >> 6), lane = tid & 63, wr = wid >> 2, wc = wid & 3, fr = lane & 15, fq = lane >> 4;
    static_assert(BLKA && BLKB, "operands are stored in LDS-image order");
    unsigned voffA[2], voffB[2];
#pragma unroll
    for (int i = 0; i < 2; ++i) { int R, C; stage_rc(tid * 16 + i * 8192, R, C); const int Rb = Epi::PERM ? ((R & ~31) + perm32(R & 31)) : R;
        (void)R; (void)C; (void)Rb; voffA[i] = (unsigned)(tid * 16 + i * 8192); voffB[i] = (unsigned)(tid * 16 + i * 8192); }
    const size_t kstep = BLKA ? (size_t)16384 : (size_t)(BK * 2);
    const size_t kstepB = BLKB ? (size_t)16384 : (size_t)(BK * 2);
    const unsigned ldsw = (unsigned)wid * 1024u;
    const int aoff = lds_byte(wr * 64 + fr, fq * 8), boff = lds_byte(wc * 32 + fr, fq * 8);
#define PG8_SA(b, h) (((b) * 2 + (h)) * HTB)
#define PG8_SB(b, h) ((4 + (b) * 2 + (h)) * HTB)
#define PG8_STAGE(bufoff, gbase, voff) do { _Pragma("unroll") for (int _i = 0; _i < 2; ++_i) \
        __builtin_amdgcn_global_load_lds((const unsigned*)((const char*)(gbase) + (voff)[_i]), (PG8_LAS unsigned*)(lds + (bufoff) + ldsw + _i * 8192), 16, 0, 0); } while (0)
#define PG8_LDA(dst, b, h) do { _Pragma("unroll") for (int m = 0; m < 4; ++m) _Pragma("unroll") for (int k = 0; k < 2; ++k) dst[m][k] = *(const PG8_LAS bf16x8*)(lds + PG8_SA(b, h) + aoff + m * 2048 + k * 1024); } while (0)
#define PG8_LDB(dst, b, h) do { _Pragma("unroll") for (int n = 0; n < 2; ++n) _Pragma("unroll") for (int k = 0; k < 2; ++k) dst[n][k] = *(const PG8_LAS bf16x8*)(lds + PG8_SB(b, h) + boff + n * 2048 + k * 1024); } while (0)
#define PG8_MMA(ai, bj, At, Bt) do { __builtin_amdgcn_s_setprio(1); _Pragma("unroll") for (int m = 0; m < 4; ++m) _Pragma("unroll") for (int n = 0; n < 2; ++n) _Pragma("unroll") for (int k = 0; k < 2; ++k) \
        acc[ai][bj][m][n] = __builtin_amdgcn_mfma_f32_16x16x32_bf16(Bt[n][k], At[m][k], acc[ai][bj][m][n], 0, 0, 0); __builtin_amdgcn_s_setprio(0); } while (0)
#define PG8_WAIT_V(n) asm volatile("s_waitcnt vmcnt(" #n ")" ::: "memory")
#define PG8_WAIT_L(n) asm volatile("s_waitcnt lgkmcnt(" #n ")" ::: "memory")
#define PG8_BAR __builtin_amdgcn_s_barrier()
#define PG8_SCHED __builtin_amdgcn_sched_barrier(0)
    Unit cur, nxt; int ti = 0;
    if (!S.tl(0, cur)) return;
    cur.seg = 0;
    f32x4 acc[2][2][4][2];
#pragma unroll
    for (int a = 0; a < 2; ++a)
#pragma unroll
        for (int b = 0; b < 2; ++b)
#pragma unroll
            for (int m = 0; m < 4; ++m)
#pragma unroll
                for (int n = 0; n < 2; ++n) acc[a][b][m][n] = (f32x4){0.f, 0.f, 0.f, 0.f};
    bf16x8 At[4][2], B0[2][2], B1[2][2];
    const char* cA; const char* cB;
    { const size_t hstep = (size_t)g.nt(0) * 16384;
    cA = g.a(0, cur.pm) + (size_t)cur.pm * (2 * hstep); cB = g.b(0) + (size_t)cur.pn * (2 * hstep);
    if constexpr (SP2) {
        PG8_STAGE(PG8_SB(0, 0), cB, voffB); PG8_STAGE(PG8_SB(0, 1), cB + hstep, voffB); PG8_STAGE(PG8_SA(0, 0), cA, voffA); PG8_STAGE(PG8_SA(0, 1), cA + hstep, voffA);
        if (wr == 1) PG8_BAR;
        PG8_WAIT_V(2); PG8_BAR;
        PG8_STAGE(PG8_SB(1, 0), cB + kstepB, voffB); PG8_STAGE(PG8_SA(1, 0), cA + kstep, voffA); PG8_STAGE(PG8_SB(1, 1), cB + hstep + kstepB, voffB);
        PG8_WAIT_V(6); PG8_BAR;
    } else {
        PG8_STAGE(PG8_SB(0, 0), cB, voffB); PG8_STAGE(PG8_SA(0, 0), cA, voffA); PG8_STAGE(PG8_SB(0, 1), cB + hstep, voffB); PG8_STAGE(PG8_SA(0, 1), cA + hstep, voffA);
        if (wr == 1) PG8_BAR;
        PG8_WAIT_V(4); PG8_BAR;
        PG8_STAGE(PG8_SB(1, 0), cB + kstepB, voffB); PG8_STAGE(PG8_SA(1, 0), cA + kstep, voffA); PG8_STAGE(PG8_SB(1, 1), cB + hstep + kstepB, voffB);
        PG8_WAIT_V(6); PG8_BAR;
    } }
    auto unit = [&](auto segc) __attribute__((always_inline)) -> bool {
        constexpr int SEG = decltype(segc)::value, NXS = (SEG + 1) % Sched::NSEG;
        if constexpr (SEG == 1) { if (ti == 0) hook(); }
        bool has_next = true;
        if constexpr (SEG + 1 < Sched::NSEG) nxt = cur; else has_next = S.tl(ti + 1, nxt);
        const int nt = g.nt(SEG), nnt = g.nt(NXS); const size_t hstep = (size_t)nt * 16384, nhstep = (size_t)nnt * 16384;
        const char* nA = has_next ? g.a(NXS, nxt.pm) + (size_t)nxt.pm * (2 * nhstep) : cA; const char* nB = has_next ? g.b(NXS) + (size_t)nxt.pn * (2 * nhstep) : cB;
        for (int t = 0; t < nt; t += 2) {
            const bool last = (t == nt - 2);
            const char* a1 = cA + (size_t)(t + 1) * kstep;
            const char* a2 = last ? nA : cA + (size_t)(t + 2) * kstep; const char* b2 = last ? nB : cB + (size_t)(t + 2) * kstepB;
            const char* a3 = a2 + kstep; const char* b3 = b2 + kstepB;
            const size_t h2 = last ? nhstep : hstep;
            if constexpr (SP2) {
            PG8_LDB(B0, 0, 0); PG8_LDB(B1, 0, 1); PG8_SCHED; PG8_LDA(At, 0, 0); PG8_STAGE(PG8_SA(1, 1), a1 + hstep, voffA);
            PG8_WAIT_V(8); PG8_WAIT_L(0); PG8_BAR; PG8_MMA(0, 0, At, B0); PG8_MMA(0, 1, At, B1); PG8_BAR; PG8_SCHED;
            PG8_LDA(At, 0, 1); PG8_STAGE(PG8_SB(0, 0), b2, voffB); PG8_STAGE(PG8_SB(0, 1), b2 + h2, voffB); PG8_STAGE(PG8_SA(0, 0), a2, voffA);
            PG8_WAIT_V(8); PG8_WAIT_L(0); PG8_BAR; PG8_MMA(1, 0, At, B0); PG8_MMA(1, 1, At, B1); PG8_BAR; PG8_SCHED;
            PG8_LDB(B0, 1, 0); PG8_LDB(B1, 1, 1); PG8_SCHED; PG8_LDA(At, 1, 0); PG8_STAGE(PG8_SA(0, 1), a2 + h2, voffA);
            PG8_WAIT_V(8); PG8_WAIT_L(0); PG8_BAR; PG8_MMA(0, 0, At, B0); PG8_MMA(0, 1, At, B1); PG8_BAR; PG8_SCHED;
            PG8_LDA(At, 1, 1); PG8_STAGE(PG8_SB(1, 0), b3, voffB); PG8_STAGE(PG8_SB(1, 1), b3 + h2, voffB); PG8_STAGE(PG8_SA(1, 0), a3, voffA);
            PG8_WAIT_V(8); PG8_WAIT_L(0); PG8_BAR; PG8_MMA(1, 0, At, B0); PG8_MMA(1, 1, At, B1); PG8_BAR; PG8_SCHED;
            } else {
            PG8_LDB(B0, 0, 0); PG8_SCHED; PG8_LDA(At, 0, 0); PG8_STAGE(PG8_SA(1, 1), a1 + hstep, voffA);
            PG8_WAIT_L(8); PG8_BAR; PG8_WAIT_L(0); PG8_MMA(0, 0, At, B0); PG8_BAR; PG8_SCHED;
            PG8_LDB(B1, 0, 1); PG8_STAGE(PG8_SB(0, 0), b2, voffB);
            PG8_BAR; PG8_WAIT_L(0); PG8_MMA(0, 1, At, B1); PG8_BAR;
            PG8_LDA(At, 0, 1); PG8_STAGE(PG8_SA(0, 0), a2, voffA);
            PG8_BAR; PG8_WAIT_L(0); PG8_MMA(1, 0, At, B0); PG8_BAR; PG8_SCHED;
            PG8_STAGE(PG8_SB(0, 1), b2 + h2, voffB);
            PG8_WAIT_V(6); PG8_BAR; PG8_MMA(1, 1, At, B1); PG8_BAR;
            PG8_LDB(B0, 1, 0); PG8_SCHED; PG8_LDA(At, 1, 0); PG8_STAGE(PG8_SA(0, 1), a2 + h2, voffA);
            PG8_WAIT_L(8); PG8_BAR; PG8_WAIT_L(0); PG8_MMA(0, 0, At, B0); PG8_BAR; PG8_SCHED;
            PG8_LDB(B1, 1, 1); PG8_STAGE(PG8_SB(1, 0), b3, voffB);
            PG8_BAR; PG8_WAIT_L(0); PG8_MMA(0, 1, At, B1); PG8_BAR;
            PG8_LDA(At, 1, 1); PG8_STAGE(PG8_SA(1, 0), a3, voffA);
            PG8_BAR; PG8_WAIT_L(0); PG8_MMA(1, 0, At, B0); PG8_BAR; PG8_SCHED;
            PG8_STAGE(PG8_SB(1, 1), b3 + h2, voffB);
            PG8_WAIT_V(6); PG8_BAR; PG8_MMA(1, 1, At, B1); PG8_BAR;
            }
        }
        if constexpr (ALIGN_EPI) { if (wr == 0) PG8_BAR; }
        Unit u = cur; u.seg = SEG;
        const bool keep = E(acc, u, wr, wc, fr, fq);
        if (!has_next) return false;
        if (!keep) {
#pragma unroll
        for (int a = 0; a < 2; ++a)
#pragma unroll
            for (int b = 0; b < 2; ++b)
#pragma unroll
                for (int m = 0; m < 4; ++m)
#pragma unroll
                    for (int n = 0; n < 2; ++n) acc[a][b][m][n] = (f32x4){0.f, 0.f, 0.f, 0.f};
        }
        cur = nxt; cA = nA; cB = nB; if constexpr (SEG + 1 == Sched::NSEG) ++ti;
        if constexpr (ALIGN_EPI) { if (wr == 1) PG8_BAR; }
        return true;
    };
    for (;;) {
        if (!unit(std::integral_constant<int, 0>{})) break;
        if constexpr (Sched::NSEG > 1) { if (!unit(std::integral_constant<int, 1>{})) break; }
        if constexpr (Sched::NSEG > 2) { if (!unit(std::integral_constant<int, 2>{})) break; if (!unit(std::integral_constant<int, 3>{})) break; }
    }
    PG8_WAIT_V(0);
    if constexpr (!ALIGN_EPI) { if (wr == 0) PG8_BAR; }
    PG8_BAR;
#undef PG8_SA
#undef PG8_SB
#undef PG8_STAGE
#undef PG8_LDA
#undef PG8_LDB
#undef PG8_MMA
#undef PG8_WAIT_V
#undef PG8_WAIT_L
#undef PG8_BAR
#undef PG8_SCHED
}
}

constexpr int NWAVES = 8;
constexpr int BATCH = 8, SEQ = 2048, DM = 2048, M = BATCH * SEQ;
constexpr int HGW = 1024, ATW = 1024, KVW = 256, INW = 4 * HGW + ATW + 2 * KVW + 2 * DM;
constexpr int DFF = 4 * DM;
constexpr float EPS = 1e-6f;
constexpr int N_PHASES = 10;

constexpr size_t MiB = 1u << 20;
constexpr size_t WS_CTL = 0, CTL_ZERO_BYTES = 128 * 1024;
constexpr size_t WS_ADA = 1 * MiB;
constexpr size_t WS_LB = WS_ADA + 512 * 1024;
constexpr size_t WS_BT = WS_LB + 4096;
constexpr size_t WS_WIN = 2 * MiB, WS_WBH = 40 * MiB, WS_WBA = 44 * MiB, WS_WOUT = 48 * MiB, WS_WFF1 = 56 * MiB, WS_WFF2 = 88 * MiB;
constexpr size_t WS_ARENA = 120 * MiB;
constexpr size_t AO_QH = 0, AO_VH = 4 * MiB, AO_LOGF = 8 * MiB, AO_GH = 16 * MiB, AO_AQ = 20 * MiB, AO_AK = 24 * MiB, AO_VT = 25 * MiB, AO_XN = 26 * MiB, AO_GSCR = 34 * MiB, AO_SLOC = 42 * MiB, AO_BSEG = 44 * MiB;
constexpr size_t AO_MERGED = 0;
constexpr size_t AO_H = 0, AO_XN2 = 32 * MiB, AO_D1 = 40 * MiB;
constexpr size_t WS_END = 504 * MiB;
constexpr int CW_BAR = 4096;
constexpr int CW_XCC = 15360;

constexpr int RING_OFF = 0, RING_BYTES = 131072;
constexpr int P0_SCR = 16640;
constexpr int LDSCTL_OFF = 8 * P0_SCR, MISC_OFF = LDSCTL_OFF + 320;
static_assert(LDSCTL_OFF >= RING_BYTES, "lds map");
constexpr int LDS_BYTES = 147456;

#define GAS __attribute__((address_space(1)))
#define LAS __attribute__((address_space(3)))
typedef unsigned short bf16;
typedef unsigned v4u __attribute__((ext_vector_type(4)));
typedef unsigned v2u __attribute__((ext_vector_type(2)));
typedef float f32x4 __attribute__((ext_vector_type(4)));
typedef float f32x16 __attribute__((ext_vector_type(16)));
typedef short bf16x8 __attribute__((ext_vector_type(8)));
typedef short s16x4 __attribute__((ext_vector_type(4)));
#define LDS_WAIT() asm volatile("s_waitcnt lgkmcnt(0)" ::: "memory")
using pg8::cvtpk; using pg8::bflo; using pg8::bfhi; using pg8::fast_exp;
__device__ __forceinline__ unsigned f2bf(float f) { return pg8::cvtpk(f, 0.f) & 0xffffu; }
__device__ __forceinline__ float bf2f(unsigned short h) { return __uint_as_float((unsigned)h << 16); }

#define XB_TMO      128
#define XB_XCNT(j)  (256  + 64 * (j))
#define XB_XSUB(j)  (1280 + 64 * (j))
#define XB_XGEN(j)  (2304 + 64 * (j))
#define XB_TOP      3328
#define XB_TOPGEN   3392
#define XCD_BAR_WORDS 3456
#define XB_SPIN_CAP (1u << 18)
__device__ __forceinline__ unsigned xb_ld(unsigned* p)              { return __hip_atomic_load(p, __ATOMIC_RELAXED, __HIP_MEMORY_SCOPE_AGENT); }
__device__ __forceinline__ unsigned xb_add(unsigned* p, unsigned v) { return __hip_atomic_fetch_add(p, v, __ATOMIC_RELAXED, __HIP_MEMORY_SCOPE_AGENT); }
__device__ __forceinline__ unsigned xb_xcc_id() { return (unsigned)__builtin_amdgcn_s_getreg((3 << 11) | 20) & 0xFu; }
#define XB_SPIN(cond, bar) do { unsigned _sp = 0; while (cond) { __builtin_amdgcn_s_sleep(1); \
    if ((++_sp & 255u) == 0u) { if (xb_ld(&(bar)[XB_TMO])) break; if (_sp > XB_SPIN_CAP) { atomicAdd(&(bar)[XB_TMO], 1u); break; } } } } while (0)
struct XcdBarrier { unsigned* bar; unsigned x; volatile LAS unsigned* st; };
__device__ __forceinline__ XcdBarrier xcd_barrier_post(unsigned* bar, volatile LAS unsigned* st) {
    XcdBarrier b; b.bar = bar; b.x = xb_xcc_id(); b.st = st;
    if (threadIdx.x == 0) (void)xb_add(&bar[XB_XCNT(b.x)], 1u);
    return b;
}
__device__ __forceinline__ void xcd_barrier_complete(unsigned* bar, unsigned x, unsigned& nloc, unsigned& nx) {
    const unsigned G = gridDim.x * gridDim.y * gridDim.z;
    unsigned sum, cnt, mine, sp = 0u;
    for (;;) {
        sum = 0u; cnt = 0u; mine = 0u;
#pragma unroll
        for (unsigned j = 0; j < 16; ++j) { const unsigned c = xb_ld(&bar[XB_XCNT(j)]); sum += c; cnt += (c > 0u) ? 1u : 0u; mine = (j == x) ? c : mine; }
        if (sum == G) break;
        __builtin_amdgcn_s_sleep(1);
        if ((++sp & 255u) == 0u) { if (xb_ld(&bar[XB_TMO])) break; if (sp > XB_SPIN_CAP) { atomicAdd(&bar[XB_TMO], 1u); break; } }
    }
    nloc = mine > 0u ? mine : 1u; nx = cnt > 0u ? cnt : 1u;
}
__device__ __forceinline__ void xcd_barrier(const XcdBarrier& b) {
    asm volatile("s_waitcnt vmcnt(0)" ::: "memory");
    __syncthreads();
    if (threadIdx.x == 0) {
        unsigned* bar = b.bar;
        __builtin_amdgcn_s_waitcnt(0);
        unsigned nloc = b.st[0], nx = b.st[1];
        if (nloc == 0u) { xcd_barrier_complete(bar, b.x, nloc, nx); b.st[0] = nloc; b.st[1] = nx; }
        const unsigned old = xb_add(&bar[XB_XSUB(b.x)], 1u);
        const unsigned gen = old / nloc;
        if (old + 1u == (gen + 1u) * nloc) {
            __builtin_amdgcn_fence(__ATOMIC_RELEASE, "agent");
            asm volatile("s_waitcnt vmcnt(0)" ::: "memory");
            const unsigned og = xb_add(&bar[XB_TOP], 1u);
            const unsigned tg = og / nx;
            if (og + 1u == (tg + 1u) * nx) xb_add(&bar[XB_TOPGEN], 1u);
            else XB_SPIN(xb_ld(&bar[XB_TOPGEN]) == tg, bar);
            __builtin_amdgcn_fence(__ATOMIC_ACQUIRE, "agent");
            xb_add(&bar[XB_XGEN(b.x)], 1u);
            asm volatile("s_waitcnt vmcnt(0)" ::: "memory");
        } else {
            XB_SPIN(xb_ld(&bar[XB_XGEN(b.x)]) == gen, bar);
            __builtin_amdgcn_fence(__ATOMIC_ACQUIRE, "agent");
            asm volatile("s_waitcnt vmcnt(0)" ::: "memory");
        }
    }
    __syncthreads();
}

__device__ __forceinline__ void xcd_barrier_local(const XcdBarrier& b) {
    asm volatile("s_waitcnt vmcnt(0)" ::: "memory");
    __syncthreads();
    if (threadIdx.x == 0) {
        unsigned* bar = b.bar;
        __builtin_amdgcn_s_waitcnt(0);
        unsigned nloc = b.st[0], nx = b.st[1];
        if (nloc == 0u) { xcd_barrier_complete(bar, b.x, nloc, nx); b.st[0] = nloc; b.st[1] = nx; }
        const unsigned old = xb_add(&bar[XB_XSUB(b.x)], 1u);
        const unsigned gen = old / nloc;
        if (old + 1u == (gen + 1u) * nloc) xb_add(&bar[XB_XGEN(b.x)], 1u);
        else XB_SPIN(xb_ld(&bar[XB_XGEN(b.x)]) == gen, bar);
        __builtin_amdgcn_fence(__ATOMIC_ACQUIRE, "agent");
        asm volatile("s_waitcnt vmcnt(0)" ::: "memory");
    }
    __syncthreads();
}

__device__ __forceinline__ unsigned xcd_barrier_local_arrive(const XcdBarrier& b) {
    asm volatile("s_waitcnt vmcnt(0)" ::: "memory");
    __syncthreads();
    unsigned tok = ~0u;
    if (threadIdx.x == 0) {
        unsigned* bar = b.bar;
        __builtin_amdgcn_s_waitcnt(0);
        unsigned nloc = b.st[0], nx = b.st[1];
        if (nloc == 0u) { xcd_barrier_complete(bar, b.x, nloc, nx); b.st[0] = nloc; b.st[1] = nx; }
        const unsigned old = xb_add(&bar[XB_XSUB(b.x)], 1u);
        const unsigned gen = old / nloc;
        if (old + 1u == (gen + 1u) * nloc) xb_add(&bar[XB_XGEN(b.x)], 1u); else tok = gen;
    }
    return tok;
}
__device__ __forceinline__ void xcd_barrier_local_wait(const XcdBarrier& b, unsigned tok) {
    if (threadIdx.x == 0) {
        unsigned* bar = b.bar;
        if (tok != ~0u) XB_SPIN(xb_ld(&bar[XB_XGEN(b.x)]) == tok, bar);
        __builtin_amdgcn_fence(__ATOMIC_ACQUIRE, "agent");
        asm volatile("s_waitcnt vmcnt(0)" ::: "memory");
    }
    __syncthreads();
}

__device__ __forceinline__ float wave_sum(float v) {
#pragma unroll
    for (int o = 1; o < 64; o <<= 1) v += __shfl_xor(v, o);
    return v;
}

struct Args { const float* in[18]; float* out; unsigned char* ws; int ph_lo, ph_hi, li, pad; };

struct TileD { const float* src; unsigned char* dst; int N, nh; };
__device__ __forceinline__ void tile_load(const TileD& d, f32x4 (&v)[16], int lane) {
    const int lr = lane >> 4, lc = 4 * (lane & 15);
#pragma unroll
    for (int i = 0; i < 16; ++i) v[i] = __builtin_nontemporal_load((const GAS f32x4*)(d.src + (size_t)(4 * i + lr) * d.N + lc));
}
__device__ __forceinline__ void tile_store(const TileD& d, const f32x4 (&v)[16], LAS float* scr, int lane) {
    const int lr = lane >> 4, lc = 4 * (lane & 15);
#pragma unroll
    for (int i = 0; i < 16; ++i) { LAS float* p = scr + (4 * i + lr) * 65 + lc; p[0] = v[i][0]; p[1] = v[i][1]; p[2] = v[i][2]; p[3] = v[i][3]; }
    LDS_WAIT(); asm volatile("" ::: "memory");
    const int c = lane & 7;
#pragma unroll
    for (int j = 0; j < 8; ++j) { const int n = (lane >> 3) + 8 * j; const LAS float* sp = scr + (8 * c) * 65 + n;
        v4u o; o.x = cvtpk(sp[0 * 65], sp[1 * 65]); o.y = cvtpk(sp[2 * 65], sp[3 * 65]); o.z = cvtpk(sp[4 * 65], sp[5 * 65]); o.w = cvtpk(sp[6 * 65], sp[7 * 65]);
        const int nn = d.nh + n, x = nn & 31, slot = (nn & ~31) + 16 * ((x >> 2) & 1) + 4 * (x >> 3) + (x & 3);
        *(GAS v4u*)(d.dst + pg8::lds_byte(slot, 8 * c)) = o; }
    LDS_WAIT(); asm volatile("" ::: "memory");
}
template <class D> __device__ __forceinline__ void transpose_items(const D& desc, int first, int stride, int end, LAS float* scr, int lane) {
    if (first >= end) return;
    const int last = first + ((end - 1 - first) / stride) * stride;
    f32x4 va[16], vb[16];
    int it = first; TileD a = desc(it), b; tile_load(a, va, lane);
    for (;;) {
        const int i2 = it + stride; b = desc(i2 < end ? i2 : last); tile_load(b, vb, lane);
        tile_store(a, va, scr, lane);
        if (i2 >= end) break;
        it = i2 + stride; a = desc(it < end ? it : last); tile_load(a, va, lane);
        tile_store(b, vb, scr, lane);
        if (it >= end) break;
    }
}
struct DescWin { const float* w; bf16* wt;
    __device__ __forceinline__ TileD operator()(int it) const { const int kb = it / (INW / 64), nb = it % (INW / 64); return TileD{w + (size_t)(64 * kb) * INW + 64 * nb, (unsigned char*)wt + ((size_t)(nb >> 1) * (DM / 64) + kb) * 16384, INW, (nb & 1) * 64}; } };
struct DescRest { const float *w_bh, *w_ba, *w_out, *w_ff1, *w_ff2; bf16 *WBH, *WBA, *WOUT, *WFF1, *WFF2;
    static constexpr int I_BH = (HGW / 64) * (DM / 64), I_OUT = (DM / 64) * (DM / 64), I_F1 = (DM / 64) * (DFF / 64), I_F2 = (DFF / 64) * (DM / 64), NITEMS = 2 * I_BH + I_OUT + I_F1 + I_F2;
    __device__ __forceinline__ TileD operator()(int it) const {
        const float* w; bf16* wt; int K, N, r = it;
        if (r < I_BH) { w = w_bh; wt = WBH; K = HGW; N = DM; }
        else if ((r -= I_BH) < I_BH) { w = w_ba; wt = WBA; K = ATW; N = DM; }
        else if ((r -= I_BH) < I_OUT) { w = w_out; wt = WOUT; K = DM; N = DM; }
        else if ((r -= I_OUT) < I_F1) { w = w_ff1; wt = WFF1; K = DM; N = DFF; }
        else { r -= I_F1; w = w_ff2; wt = WFF2; K = DFF; N = DM; }
        const int nblk = N / 64, kb = r / nblk, nb = r % nblk;
        return TileD{w + (size_t)(64 * kb) * N + 64 * nb, (unsigned char*)wt + ((size_t)(nb >> 1) * (K / 64) + kb) * 16384, N, (nb & 1) * 64}; } };

__device__ __forceinline__ void p0_ada(LAS unsigned char* lds, const float* c, const float* w_ada, const float* b_ada, float* ada, int blk, int tid) {
    LAS float* cact = (LAS float*)lds;
    LAS float* red = (LAS float*)(lds + 65536);
    for (int i = tid; i < 8 * 2048; i += 512) { const int b = i >> 11, k = i & 2047; const float x = c[i]; cact[k * 8 + b] = x * pg8::sigmoidf_(x); }
    __syncthreads();
    const int cq = tid & 15, kg = tid >> 4;
    f32x4 acc[8];
#pragma unroll
    for (int b = 0; b < 8; ++b) acc[b] = (f32x4){0.f, 0.f, 0.f, 0.f};
    const float* wp = w_ada + (size_t)kg * 12288 + 64 * blk + 4 * cq;
#pragma unroll 8
    for (int i = 0; i < 64; ++i) {
        const f32x4 w = __builtin_nontemporal_load((const f32x4*)(wp + (size_t)i * 32 * 12288));
        const int k = kg + 32 * i;
        const f32x4 c0 = *(const LAS f32x4*)(cact + k * 8), c1 = *(const LAS f32x4*)(cact + k * 8 + 4);
        acc[0] += w * c0[0]; acc[1] += w * c0[1]; acc[2] += w * c0[2]; acc[3] += w * c0[3];
        acc[4] += w * c1[0]; acc[5] += w * c1[1]; acc[6] += w * c1[2]; acc[7] += w * c1[3];
    }
#pragma unroll
    for (int b = 0; b < 8; ++b) *(LAS f32x4*)(red + (kg * 8 + b) * 64 + 4 * cq) = acc[b];
    __syncthreads();
    { const int b = tid >> 6, col = tid & 63; float s = 0.f;
#pragma unroll 8
      for (int g = 0; g < 32; ++g) s += red[(g * 8 + b) * 64 + col];
      ada[b * 12288 + 64 * blk + col] = s + b_ada[64 * blk + col]; }
    __syncthreads();
}

template <bool DELTA>
__device__ __forceinline__ void norm_rows(const float* src, const bf16* delta, const float* g, const float* shift, const float* scale, bf16* dst, int bx, int wave, int lane) {
    const int b = bx & 7, r0 = (bx >> 3) * NWAVES + wave;
    const float* shb = shift + b * 12288; const float* scb = scale + b * 12288;
    constexpr bool HOIST = !DELTA;
    f32x4 gm[8], shv[8];
    if constexpr (HOIST) {
#pragma unroll
    for (int j = 0; j < 8; ++j) { const int col = 4 * lane + 256 * j; gm[j] = *(const f32x4*)(g + col) * (*(const f32x4*)(scb + col) + 1.0f); shv[j] = *(const f32x4*)(shb + col); } }
    for (int k = 0; k < 8; k += 2) {
        const int m0 = b * SEQ + r0 + 256 * k, m1 = m0 + 256;
        const GAS f32x4* x0 = (const GAS f32x4*)(src + (size_t)m0 * DM) + lane; const GAS f32x4* x1 = (const GAS f32x4*)(src + (size_t)m1 * DM) + lane;
        f32x4 v0[8], v1[8];
#pragma unroll
        for (int j = 0; j < 8; ++j) { v0[j] = __builtin_nontemporal_load(&x0[64 * j]); v1[j] = __builtin_nontemporal_load(&x1[64 * j]); }
        if (DELTA) {
            const GAS v2u* d0 = (const GAS v2u*)(delta + (size_t)m0 * DM) + lane; const GAS v2u* d1 = (const GAS v2u*)(delta + (size_t)m1 * DM) + lane;
            v2u e0[8], e1[8];
#pragma unroll
            for (int j = 0; j < 8; ++j) { e0[j] = d0[64 * j]; e1[j] = d1[64 * j]; }
#pragma unroll
            for (int j = 0; j < 8; ++j) { v0[j].x += bflo(e0[j].x); v0[j].y += bfhi(e0[j].x); v0[j].z += bflo(e0[j].y); v0[j].w += bfhi(e0[j].y);
                                          v1[j].x += bflo(e1[j].x); v1[j].y += bfhi(e1[j].x); v1[j].z += bflo(e1[j].y); v1[j].w += bfhi(e1[j].y); }
        }
        float s0 = 0.f, s1 = 0.f;
#pragma unroll
        for (int j = 0; j < 8; ++j) { s0 += (v0[j].x * v0[j].x + v0[j].y * v0[j].y) + (v0[j].z * v0[j].z + v0[j].w * v0[j].w); s1 += (v1[j].x * v1[j].x + v1[j].y * v1[j].y) + (v1[j].z * v1[j].z + v1[j].w * v1[j].w); }
        const float ra = rsqrtf(wave_sum(s0) * (1.f / DM) + EPS), rb = rsqrtf(wave_sum(s1) * (1.f / DM) + EPS);
        GAS unsigned char* o0 = (GAS unsigned char*)dst + ((size_t)(m0 >> 7) * (DM / 64)) * 16384; GAS unsigned char* o1 = (GAS unsigned char*)dst + ((size_t)(m1 >> 7) * (DM / 64)) * 16384;
#pragma unroll
        for (int j = 0; j < 8; ++j) { const int col = 4 * lane + 256 * j;
            f32x4 gmj, shj;
            if constexpr (HOIST) { gmj = gm[j]; shj = shv[j]; } else { gmj = *(const f32x4*)(g + col) * (*(const f32x4*)(scb + col) + 1.0f); shj = *(const f32x4*)(shb + col); }
            const f32x4 ya = (v0[j] * ra) * gmj + shj, yb = (v1[j] * rb) * gmj + shj;
            v2u wa, wb; wa.x = cvtpk(ya.x, ya.y); wa.y = cvtpk(ya.z, ya.w); wb.x = cvtpk(yb.x, yb.y); wb.y = cvtpk(yb.z, yb.w);
            *(GAS v2u*)(o0 + (size_t)(col >> 6) * 16384 + pg8::lds_byte(m0 & 127, col & 63)) = wa; *(GAS v2u*)(o1 + (size_t)(col >> 6) * 16384 + pg8::lds_byte(m1 & 127, col & 63)) = wb; }
    }
}

namespace hg {
constexpr int QS = 144, TS = 80;
constexpr int OFF_QT = 0, OFF_KT = 64 * QS * 2, OFF_KTT = 2 * OFF_KT, OFF_VT = OFF_KTT + 128 * TS * 2, OFF_P = OFF_VT + 128 * TS * 2, OFF_ST = OFF_P + 64 * TS * 2, OFF_SEG = OFF_ST + 128 * QS * 2, OFF_FAC = OFF_SEG + 4096, LDS_END = OFF_FAC + 1536;
static_assert(LDS_END <= RING_BYTES, "hgrn lds");
__device__ __forceinline__ bf16x8 ldfrag(const LAS unsigned char* base, int row, int stride, int k) { return *(const LAS bf16x8*)(base + (row * stride + k) * 2); }
#define MFMA16(a, b, c) __builtin_amdgcn_mfma_f32_16x16x32_bf16((a), (b), (c), 0, 0, 0)
typedef float f32x2 __attribute__((ext_vector_type(2)));

__device__ __forceinline__ void hgrn_seg(LAS unsigned char* lds, int bh, int j, const bf16* QH, const float* LOGF, const bf16* VH, bf16* OLOC, bf16* QC, float* SLOC, float* BSEG) {
    const int tid = threadIdx.x, lane = tid & 63, w = __builtin_amdgcn_readfirstlane(tid >> 6);
    const int b = bh >> 3, h = bh & 7;
    const int d0 = 2 * lane;
    const int l15 = lane & 15, lq = lane >> 4;
    LAS float* SEG = (LAS float*)(lds + OFF_SEG); LAS float* FAC = (LAS float*)(lds + OFF_FAC);
    const size_t colh = (size_t)h * 128;
    const size_t rowb = (size_t)b * SEQ + (size_t)j * 512;
    f32x2 lf[8]; unsigned qv[8], vv[8];
    { const size_t base = (rowb + 8 * w) * 1024 + colh + d0;
#pragma unroll
      for (int i = 0; i < 8; ++i) { lf[i] = *(const f32x2*)(LOGF + base + (size_t)i * 1024); qv[i] = *(const unsigned*)(QH + base + (size_t)i * 1024); vv[i] = *(const unsigned*)(VH + base + (size_t)i * 1024); } }
    f32x4 S[8];
#pragma unroll
    for (int i = 0; i < 8; ++i) S[i] = (f32x4){0.f, 0.f, 0.f, 0.f};
    const int tt = w & 3, vh = w >> 2;
    f32x2 coff = (f32x2){0.f, 0.f};

    for (int n = 0; n < 8; ++n) {
        { f32x2 run = (f32x2){0.f, 0.f};
#pragma unroll
          for (int i = 0; i < 8; ++i) run += lf[i];
          *(LAS f32x2*)(SEG + w * 128 + d0) = run; }
        __syncthreads();
        {
            f32x2 off = (f32x2){0.f, 0.f}, ref = (f32x2){0.f, 0.f}, blast = (f32x2){0.f, 0.f};
#pragma unroll
            for (int k = 0; k < 8; ++k) { const f32x2 sk = *(const LAS f32x2*)(SEG + k * 128 + d0); if (k < w) off += sk; if (k < 4) ref += sk; blast += sk; }
            if (w == 0) {
                *(LAS f32x2*)(FAC + d0) = (f32x2){fast_exp(ref.x), fast_exp(ref.y)};
                *(LAS f32x2*)(FAC + 128 + d0) = (f32x2){fast_exp(blast.x), fast_exp(blast.y)};
                *(LAS f32x2*)(FAC + 256 + d0) = (f32x2){fast_exp(blast.x - ref.x), fast_exp(blast.y - ref.y)}; }
            const float X0 = fast_exp(ref.x + coff.x), X1 = fast_exp(ref.y + coff.y);
            coff += blast;
            unsigned kA[4], kB[4], vA[4], vB[4];
            float E0 = fast_exp(off.x - ref.x), E1 = fast_exp(off.y - ref.y);
            bf16* qcp = QC + (rowb + 64 * n + 8 * w) * 1024 + colh + d0;
#pragma unroll
            for (int i = 0; i < 8; i += 2) {
                float kt[2][2];
#pragma unroll
                for (int e = 0; e < 2; ++e) {
                    const float f0 = fast_exp(lf[i + e].x), f1 = fast_exp(lf[i + e].y);
                    E0 *= f0; E1 *= f1;
                    const float q0 = bflo(qv[i + e]) * E0, q1 = bfhi(qv[i + e]) * E1;
                    kt[e][0] = (1.0f - f0) * __builtin_amdgcn_rcpf(E0); kt[e][1] = (1.0f - f1) * __builtin_amdgcn_rcpf(E1);
                    const int t = 8 * w + i + e;
                    *(LAS unsigned*)(lds + OFF_QT + (t * QS + d0) * 2) = cvtpk(q0, q1);
                    *(LAS unsigned*)(lds + OFF_KT + (t * QS + d0) * 2) = cvtpk(kt[e][0], kt[e][1]);
                    *(unsigned*)(qcp + (size_t)(i + e) * 1024) = cvtpk(q0 * X0, q1 * X1);
                }
                kA[i >> 1] = cvtpk(kt[0][0], kt[1][0]); kB[i >> 1] = cvtpk(kt[0][1], kt[1][1]);
                vA[i >> 1] = (vv[i] & 0xffffu) | (vv[i + 1] << 16); vB[i >> 1] = (vv[i] >> 16) | (vv[i + 1] & 0xffff0000u);
            }
            *(LAS v4u*)(lds + OFF_KTT + (d0 * TS + 8 * w) * 2) = (v4u){kA[0], kA[1], kA[2], kA[3]};
            *(LAS v4u*)(lds + OFF_KTT + ((d0 + 1) * TS + 8 * w) * 2) = (v4u){kB[0], kB[1], kB[2], kB[3]};
            *(LAS v4u*)(lds + OFF_VT + (d0 * TS + 8 * w) * 2) = (v4u){vA[0], vA[1], vA[2], vA[3]};
            *(LAS v4u*)(lds + OFF_VT + ((d0 + 1) * TS + 8 * w) * 2) = (v4u){vB[0], vB[1], vB[2], vB[3]};
        }
        { const int nn = (n + 1 < 8) ? n + 1 : n;
          const size_t base = (rowb + 64 * nn + 8 * w) * 1024 + colh + d0;
#pragma unroll
            for (int i = 0; i < 8; ++i) { lf[i] = *(const f32x2*)(LOGF + base + (size_t)i * 1024); qv[i] = *(const unsigned*)(QH + base + (size_t)i * 1024); vv[i] = *(const unsigned*)(VH + base + (size_t)i * 1024); } }
        __syncthreads();
        {
            const int ti = w >> 1;
#pragma unroll
            for (int jj = 0; jj < 2; ++jj) { const int si = 2 * (w & 1) + jj; f32x4 a = (f32x4){0.f, 0.f, 0.f, 0.f};
                if (si <= ti) {
#pragma unroll
                    for (int ks = 0; ks < 4; ++ks) a = MFMA16(ldfrag(lds + OFF_KT, 16 * si + l15, QS, 32 * ks + 8 * lq), ldfrag(lds + OFF_QT, 16 * ti + l15, QS, 32 * ks + 8 * lq), a); }
                const int t = 16 * ti + l15, s0 = 16 * si + 4 * lq;
                v2u pw; pw.x = cvtpk(s0 <= t ? a[0] : 0.f, s0 + 1 <= t ? a[1] : 0.f); pw.y = cvtpk(s0 + 2 <= t ? a[2] : 0.f, s0 + 3 <= t ? a[3] : 0.f);
                *(LAS v2u*)(lds + OFF_P + (t * TS + s0) * 2) = pw; }
#pragma unroll
            for (int dt = 0; dt < 8; ++dt) { const f32x4 e = *(const LAS f32x4*)(FAC + 16 * dt + 4 * lq);
                S[dt] = S[dt] * e;
                v2u sw; sw.x = cvtpk(S[dt][0], S[dt][1]); sw.y = cvtpk(S[dt][2], S[dt][3]);
                *(LAS v2u*)(lds + OFF_ST + ((16 * w + l15) * QS + 16 * dt + 4 * lq) * 2) = sw; }
        }
        __syncthreads();
        {
            f32x4 o[4];
#pragma unroll
            for (int vt = 0; vt < 4; ++vt) o[vt] = (f32x4){0.f, 0.f, 0.f, 0.f};
#pragma unroll
            for (int ks = 0; ks < 2; ++ks) { const bf16x8 pb = ldfrag(lds + OFF_P, 16 * tt + l15, TS, 32 * ks + 8 * lq);
#pragma unroll
                for (int vt = 0; vt < 4; ++vt) o[vt] = MFMA16(ldfrag(lds + OFF_VT, 16 * (4 * vh + vt) + l15, TS, 32 * ks + 8 * lq), pb, o[vt]); }
#pragma unroll
            for (int ks = 0; ks < 4; ++ks) { const bf16x8 qb = ldfrag(lds + OFF_QT, 16 * tt + l15, QS, 32 * ks + 8 * lq);
#pragma unroll
                for (int vt = 0; vt < 4; ++vt) o[vt] = MFMA16(ldfrag(lds + OFF_ST, 16 * (4 * vh + vt) + l15, QS, 32 * ks + 8 * lq), qb, o[vt]); }
#pragma unroll
            for (int ks = 0; ks < 2; ++ks) { const bf16x8 vb = ldfrag(lds + OFF_VT, 16 * w + l15, TS, 32 * ks + 8 * lq);
#pragma unroll
                for (int dt = 0; dt < 8; ++dt) S[dt] = MFMA16(ldfrag(lds + OFF_KTT, 16 * dt + l15, TS, 32 * ks + 8 * lq), vb, S[dt]); }
#pragma unroll
            for (int dt = 0; dt < 8; ++dt) S[dt] = S[dt] * *(const LAS f32x4*)(FAC + 256 + 16 * dt + 4 * lq);
            bf16* op = OLOC + (rowb + 64 * n + 16 * tt + l15) * 1024 + colh + 64 * vh + 4 * lq;
#pragma unroll
            for (int vt = 0; vt < 4; ++vt) { v2u wv; wv.x = cvtpk(o[vt][0], o[vt][1]); wv.y = cvtpk(o[vt][2], o[vt][3]); *(v2u*)(op + 16 * vt) = wv; }
        }
    }
    { float* sp = SLOC + ((size_t)(bh * 4 + j) * 128 + 16 * w + l15) * 128 + 4 * lq;
#pragma unroll
      for (int dt = 0; dt < 8; ++dt) *(f32x4*)(sp + 16 * dt) = S[dt];
      if (w == 0) *(f32x2*)(BSEG + (size_t)(bh * 4 + j) * 128 + d0) = coff; }
    __syncthreads();
}

constexpr int OFF_SI = 0;
__device__ __forceinline__ void hgrn_fix(LAS unsigned char* lds, int bh, int j, const bf16* OLOC, const bf16* QC, const float* SLOC, const float* BSEG, const bf16* GH, const float* gout, bf16* OHG) {
    const int tid = threadIdx.x, lane = tid & 63, w = __builtin_amdgcn_readfirstlane(tid >> 6);
    const int b = bh >> 3, h = bh & 7;
    const int l15 = lane & 15, lq = lane >> 4;
    const size_t colh = (size_t)h * 128;
    const size_t rowb = (size_t)b * SEQ + (size_t)j * 512;
    if (j > 0) {
        const int v = tid >> 2, dq = 32 * (tid & 3);
        f32x4 a[8];
        { const float* sp = SLOC + ((size_t)(bh * 4) * 128 + v) * 128 + dq;
#pragma unroll
          for (int i = 0; i < 8; ++i) a[i] = *(const f32x4*)(sp + 4 * i); }
        for (int sg = 1; sg < j; ++sg) {
            const float* sp = SLOC + ((size_t)(bh * 4 + sg) * 128 + v) * 128 + dq; const float* bp = BSEG + (size_t)(bh * 4 + sg) * 128 + dq;
#pragma unroll
            for (int i = 0; i < 8; ++i) { const f32x4 bs = *(const f32x4*)(bp + 4 * i), sl = *(const f32x4*)(sp + 4 * i);
                a[i][0] = a[i][0] * fast_exp(bs[0]) + sl[0]; a[i][1] = a[i][1] * fast_exp(bs[1]) + sl[1]; a[i][2] = a[i][2] * fast_exp(bs[2]) + sl[2]; a[i][3] = a[i][3] * fast_exp(bs[3]) + sl[3]; }
        }
#pragma unroll
        for (int i = 0; i < 8; i += 2) { v4u wv; wv.x = cvtpk(a[i][0], a[i][1]); wv.y = cvtpk(a[i][2], a[i][3]); wv.z = cvtpk(a[i + 1][0], a[i + 1][1]); wv.w = cvtpk(a[i + 1][2], a[i + 1][3]);
            *(LAS v4u*)(lds + OFF_SI + (v * QS + dq + 4 * i) * 2) = wv; }
    }
    __syncthreads();
    f32x4 gg[8];
#pragma unroll
    for (int vt = 0; vt < 8; ++vt) gg[vt] = *(const f32x4*)(gout + 16 * vt + 4 * lq);
#define FIX_LOAD(I4, OL, GT, QB) do { const size_t rb_ = (rowb + 64 * w + 16 * (I4) + l15) * 1024 + colh; \
        _Pragma("unroll") for (int vt = 0; vt < 8; ++vt) { OL[vt] = *(const v2u*)(OLOC + rb_ + 16 * vt + 4 * lq); GT[vt] = *(const v2u*)(GH + rb_ + 16 * vt + 4 * lq); } \
        if (j > 0) { _Pragma("unroll") for (int ks = 0; ks < 4; ++ks) QB[ks] = *(const bf16x8*)(QC + rb_ + 32 * ks + 8 * lq); } } while (0)
#define FIX_PROC(I4, OL, GT, QB) do { const int t = 64 * w + 16 * (I4) + l15; \
        f32x4 o[8]; \
        _Pragma("unroll") for (int vt = 0; vt < 8; ++vt) o[vt] = (f32x4){0.f, 0.f, 0.f, 0.f}; \
        if (j > 0) { _Pragma("unroll") for (int ks = 0; ks < 4; ++ks) { _Pragma("unroll") for (int vt = 0; vt < 8; ++vt) o[vt] = MFMA16(ldfrag(lds + OFF_SI, 16 * vt + l15, QS, 32 * ks + 8 * lq), QB[ks], o[vt]); } } \
        float ss = 0.f; \
        _Pragma("unroll") for (int vt = 0; vt < 8; ++vt) { o[vt][0] += bflo(OL[vt].x); o[vt][1] += bfhi(OL[vt].x); o[vt][2] += bflo(OL[vt].y); o[vt][3] += bfhi(OL[vt].y); \
            ss += (o[vt][0] * o[vt][0] + o[vt][1] * o[vt][1]) + (o[vt][2] * o[vt][2] + o[vt][3] * o[vt][3]); } \
        ss += __shfl_xor(ss, 16); ss += __shfl_xor(ss, 32); \
        const float r = rsqrtf(ss * (1.f / 128.f) + EPS); \
        _Pragma("unroll") for (int vt = 0; vt < 8; ++vt) { v2u wv; \
            wv.x = cvtpk(o[vt][0] * r * gg[vt][0] * bflo(GT[vt].x), o[vt][1] * r * gg[vt][1] * bfhi(GT[vt].x)); \
            wv.y = cvtpk(o[vt][2] * r * gg[vt][2] * bflo(GT[vt].y), o[vt][3] * r * gg[vt][3] * bfhi(GT[vt].y)); \
            *(v2u*)((char*)OHG + pg8::blk_off((int)(rowb + t), (int)colh + 16 * vt + 4 * lq, HGW / 64)) = wv; } } while (0)
    { v2u olA[8], gtA[8], olB[8], gtB[8]; bf16x8 qbA[4], qbB[4];
      FIX_LOAD(0, olA, gtA, qbA); FIX_LOAD(1, olB, gtB, qbB);
      FIX_PROC(0, olA, gtA, qbA); FIX_LOAD(2, olA, gtA, qbA);
      FIX_PROC(1, olB, gtB, qbB); FIX_LOAD(3, olB, gtB, qbB);
      FIX_PROC(2, olA, gtA, qbA);
      FIX_PROC(3, olB, gtB, qbB); }
#undef FIX_LOAD
#undef FIX_PROC
    __syncthreads();
}
}

namespace at {
#define MFMA32(a, b, c) __builtin_amdgcn_mfma_f32_32x32x16_bf16((a), (b), (c), 0, 0, 0)
__device__ __forceinline__ int crow(int r, int hi) { return (r & 3) + 8 * (r >> 2) + 4 * hi; }
constexpr float NEG = -1e30f;
constexpr float L2E = 1.4426950408889634f;
constexpr int KS = 72, VS = 264;
constexpr int OFF_K = 0, OFF_V = 256 * KS * 2  , OFF_BT = OFF_V + 64 * VS * 2  , BTS = 192, OFF_QK = OFF_BT + 16 * BTS * 4, LDS_END = OFF_QK + 256;
static_assert(LDS_END <= RING_BYTES, "attn lds");
__device__ __forceinline__ void attn_unit(LAS unsigned char* lds, int unit, const bf16* AQ, const bf16* AK, const bf16* VT, bf16* OAT, const float* qg, const float* kg, const float* sinks) {
    const int tid = threadIdx.x, lane = tid & 63, r = lane & 31, hh = lane >> 5, w = __builtin_amdgcn_readfirstlane(tid >> 6);
    const int nq = unit & 15, kvh = (unit >> 4) & 3, b = unit >> 6;
    const int kbase = 128 * (nq - 1);
    v4u qraw[4];
    { const int g0 = w >> 1, h0 = kvh * 4 + g0, qi0 = 2 * (w & 1);
      const bf16* qp = AQ + (size_t)(b * SEQ + 128 * nq + 32 * qi0 + r) * 1024 + h0 * 64 + 8 * hh;
#pragma unroll
      for (int ks = 0; ks < 4; ++ks) qraw[ks] = *(const v4u*)(qp + 16 * ks); }
    const float sink_raw = sinks[kvh * 4 + (w >> 1)];
    { const int c = tid & 7, cv = tid & 31;
      v4u kraw[4], vraw[4];
#pragma unroll
      for (int p = 0; p < 4; ++p) { const int key = 64 * p + (tid >> 3); const int kk = (kbase + key) < 0 ? 0 : (kbase + key);
          kraw[p] = *(const v4u*)(AK + (size_t)(b * SEQ + kk) * 256 + kvh * 64 + 8 * c); }
#pragma unroll
      for (int p = 0; p < 4; ++p) { const int d = 16 * p + (tid >> 5); const int tk = (kbase + 8 * cv) < 0 ? 0 : (kbase + 8 * cv);
          vraw[p] = *(const v4u*)(VT + (size_t)((b * 4 + kvh) * 64 + d) * SEQ + tk); }
      __builtin_amdgcn_sched_barrier(0);
#pragma unroll
      for (int p = 0; p < 4; ++p) { const int key = 64 * p + (tid >> 3); const v4u raw = kraw[p];
          float ss = 0.f;
#pragma unroll
          for (int e = 0; e < 4; ++e) { const float a0 = bflo(raw[e]), a1 = bfhi(raw[e]); ss += a0 * a0 + a1 * a1; }
          ss += __shfl_xor(ss, 1); ss += __shfl_xor(ss, 2); ss += __shfl_xor(ss, 4);
          const float rk = rsqrtf(ss * (1.f / 64.f) + EPS);
          v4u o;
#pragma unroll
          for (int e = 0; e < 4; ++e) o[e] = cvtpk(bflo(raw[e]) * rk, bfhi(raw[e]) * rk);
          *(LAS v4u*)(lds + OFF_K + (key * KS + 8 * c) * 2) = o; }
#pragma unroll
      for (int p = 0; p < 4; ++p) { const int d = 16 * p + (tid >> 5); *(LAS v4u*)(lds + OFF_V + (d * VS + 8 * cv) * 2) = vraw[p]; } }
    __syncthreads();
    const int g = w >> 1, h = kvh * 4 + g;
    const LAS float* qk = (const LAS float*)(lds + OFF_QK);
    const float sink = sink_raw * L2E;
    const LAS float* btl = (const LAS float*)(lds + OFF_BT) + h * BTS + r - 4 * hh;
#pragma unroll 1
    for (int qq = 0; qq < 2; ++qq) {
        const int qi = 2 * (w & 1) + qq;
        const int t0 = 128 * nq + 32 * qi;
        const int kt_lo = (nq == 0) ? 4 - qi : 0;
        bf16x8 qf[4];
        { v4u raw[4]; float ss = 0.f;
#pragma unroll
          for (int ks = 0; ks < 4; ++ks) { raw[ks] = qraw[ks];
#pragma unroll
              for (int e = 0; e < 4; ++e) { const float a0 = bflo(raw[ks][e]), a1 = bfhi(raw[ks][e]); ss += a0 * a0 + a1 * a1; } }
          ss += __shfl_xor(ss, 32);
          const float rq = rsqrtf(ss * (1.f / 64.f) + EPS);
#pragma unroll
          for (int ks = 0; ks < 4; ++ks) { v4u o; const f32x4 s0 = *(const LAS f32x4*)(qk + 16 * ks + 8 * hh), s1 = *(const LAS f32x4*)(qk + 16 * ks + 8 * hh + 4);
              o[0] = cvtpk(bflo(raw[ks][0]) * rq * s0[0], bfhi(raw[ks][0]) * rq * s0[1]); o[1] = cvtpk(bflo(raw[ks][1]) * rq * s0[2], bfhi(raw[ks][1]) * rq * s0[3]);
              o[2] = cvtpk(bflo(raw[ks][2]) * rq * s1[0], bfhi(raw[ks][2]) * rq * s1[1]); o[3] = cvtpk(bflo(raw[ks][3]) * rq * s1[2], bfhi(raw[ks][3]) * rq * s1[3]);
              qf[ks] = __builtin_bit_cast(bf16x8, o); } }
        f32x16 Sv[5];
#pragma unroll
        for (int kt = 0; kt < 5; ++kt) {
            if (kt >= kt_lo) {
                const LAS unsigned char* kp = lds + OFF_K + ((32 * (qi + kt) + r) * KS + 8 * hh) * 2;
                f32x16 a;
#pragma unroll
                for (int i = 0; i < 16; ++i) { const int cst = 128 - 32 * kt - (i & 3) - 8 * (i >> 2); a[i] = btl[32 + cst]; }
#pragma unroll
                for (int ks = 0; ks < 4; ++ks) a = MFMA32(*(const LAS bf16x8*)(kp + 32 * ks), qf[ks], a);
                Sv[kt] = a;
                if (kt == 2) __builtin_amdgcn_sched_barrier(0);
            } else {
#pragma unroll
                for (int i = 0; i < 16; ++i) Sv[kt][i] = NEG;
            }
        }
        float mx = sink;
#pragma unroll
        for (int kt = 0; kt < 5; ++kt)
#pragma unroll
            for (int i = 0; i < 16; ++i) mx = fmaxf(mx, Sv[kt][i]);
        mx = fmaxf(mx, __shfl_xor(mx, 32));
        float l = 0.f;
#pragma unroll
        for (int kt = 0; kt < 5; ++kt)
#pragma unroll
            for (int i = 0; i < 16; ++i) { const float p = __builtin_amdgcn_exp2f(Sv[kt][i] - mx); Sv[kt][i] = p; l += p; }
        l += __shfl_xor(l, 32);
        l += __builtin_amdgcn_exp2f(sink - mx);
        const float inv = 1.0f / l;
        { const bf16* qp = AQ + (size_t)(b * SEQ + t0 + 32 * (1 - qq) + r) * 1024 + h * 64 + 8 * hh;
#pragma unroll
          for (int ks = 0; ks < 4; ++ks) qraw[ks] = *(const v4u*)(qp + 16 * ks); }
        f32x16 O[2];
#pragma unroll
        for (int i = 0; i < 16; ++i) { O[0][i] = 0.f; O[1][i] = 0.f; }
#pragma unroll
        for (int kt = 0; kt < 5; ++kt) {
            if (kt >= kt_lo) {
#pragma unroll
                for (int s2 = 0; s2 < 2; ++s2) {
                    v4u pw;
#pragma unroll
                    for (int e = 0; e < 4; ++e) pw[e] = cvtpk(Sv[kt][8 * s2 + 2 * e], Sv[kt][8 * s2 + 2 * e + 1]);
                    const bf16x8 pb = __builtin_bit_cast(bf16x8, pw);
#pragma unroll
                    for (int dt = 0; dt < 2; ++dt) { const LAS unsigned char* vp = lds + OFF_V + ((32 * dt + r) * VS + 32 * (qi + kt) + 16 * s2 + 4 * hh) * 2;
                        const v2u lo = *(const LAS v2u*)(vp), hi = *(const LAS v2u*)(vp + 16);
                        const v4u va = (v4u){lo.x, lo.y, hi.x, hi.y};
                        O[dt] = MFMA32(__builtin_bit_cast(bf16x8, va), pb, O[dt]); }
                }
                if (kt & 1) __builtin_amdgcn_sched_barrier(0);
            }
        }
#pragma unroll
        for (int dt = 0; dt < 2; ++dt)
#pragma unroll
            for (int g4 = 0; g4 < 4; ++g4) { v2u wv; wv.x = cvtpk(O[dt][4 * g4] * inv, O[dt][4 * g4 + 1] * inv); wv.y = cvtpk(O[dt][4 * g4 + 2] * inv, O[dt][4 * g4 + 3] * inv);
                *(v2u*)((char*)OAT + pg8::blk_off(b * SEQ + t0 + r, h * 64 + 4 * hh + 32 * dt + 8 * g4, ATW / 64)) = wv; }
    }
    __syncthreads();
}
}

__global__ void __launch_bounds__(NWAVES * 64, 2) hyb_fwd(Args args) {
    extern __shared__ __attribute__((aligned(16))) unsigned char lds_raw[];
    LAS unsigned char* lds = (LAS unsigned char*)lds_raw;
    volatile LAS unsigned* MISC = (volatile LAS unsigned*)(lds + MISC_OFF);
    const int tid = threadIdx.x, lane = tid & 63, wave = __builtin_amdgcn_readfirstlane(tid >> 6);
    const int G = gridDim.x; const int bx = blockIdx.x; const int vcu = (G % 8 == 0) ? (bx % 8) * (G / 8) + bx / 8 : bx;
    unsigned char* ws = args.ws;
    unsigned* ctl = (unsigned*)(ws + WS_CTL);
    for (int u = tid; u < (LDS_BYTES - LDSCTL_OFF) / 4; u += NWAVES * 64) ((LAS unsigned*)(lds + LDSCTL_OFF))[u] = 0u;
    __syncthreads();
    XcdBarrier bar; bar.bar = ctl + CW_BAR + args.li * XCD_BAR_WORDS; bar.x = 0; bar.st = nullptr;
    if (MK_N_LAUNCHES != N_PHASES) bar = xcd_barrier_post(ctl + CW_BAR + args.li * XCD_BAR_WORDS, MISC + 8);
#ifndef LOCAL_SEAMS
#define LOCAL_SEAMS 0x1fa
#endif
    unsigned* xcctab = ctl + CW_XCC + args.li * 256;
    if (MK_N_LAUNCHES != N_PHASES && tid == 0) __hip_atomic_store(xcctab + bx, xb_xcc_id() + 1u, __ATOMIC_RELAXED, __HIP_MEMORY_SCOPE_AGENT);
    int canon = -1;
#define GRID_BAR_FULL() do { if (MK_N_LAUNCHES != N_PHASES) { xcd_barrier(bar); \
        if (canon < 0) { if (wave == 0) { \
                unsigned me_[4]; for (int q_ = 0; q_ < 4; ++q_) me_[q_] = __hip_atomic_load(xcctab + lane + 64 * q_, __ATOMIC_RELAXED, __HIP_MEMORY_SCOPE_AGENT);     \
                const unsigned rep_ = __hip_atomic_load(xcctab + (lane & 7), __ATOMIC_RELAXED, __HIP_MEMORY_SCOPE_AGENT);                                             \
                bool ok = (G == 256) & (rep_ != 0u) & (me_[0] == rep_) & (me_[1] == rep_) & (me_[2] == rep_) & (me_[3] == rep_); \
                for (int o_ = 1; o_ < 8; ++o_) ok = ok & (rep_ != (unsigned)__shfl(rep_, (lane + o_) & 7));                                                          \
                ok = __all(ok); if (lane == 0) MISC[11] = ok ? 1u : 0u; } \
            __syncthreads(); canon = (int)MISC[11]; } } } while (0)
#define GRID_BAR(k) do { if (MK_N_LAUNCHES != N_PHASES) { if (((LOCAL_SEAMS >> (k)) & 1) && canon == 1) xcd_barrier_local(bar); else GRID_BAR_FULL(); } } while (0)
    const int lo = args.ph_lo, hi = args.ph_hi;
#ifndef PH_MASK
#define PH_MASK 0xfff
#endif
#ifndef P3_MASK
#define P3_MASK 3
#endif
#define IN(k) (((PH_MASK >> (k)) & 1) && lo <= (k) && (k) < hi)
#define BOTH(k) (IN(k) && IN((k) + 1))
#ifndef REP_MASK
#define REP_MASK 0
#endif
#define REP(k) for (int rep_ = 0; rep_ < (((REP_MASK >> (k)) & 1) ? 2 : 1); ++rep_)
#define SEAM(k) do { if (BOTH(k) || rep_ == 0 && ((REP_MASK >> (k)) & 1)) GRID_BAR(k); } while (0)
    const float* x = args.in[0]; const float* c = args.in[1]; const float* w_ada = args.in[2]; const float* b_ada = args.in[3];
    const float* norm1_g = args.in[4]; const float* norm2_g = args.in[5]; const float* w_in = args.in[6]; const float* lb_logits = args.in[7];
    const float* hg_out_g = args.in[8]; const float* q_norm_g = args.in[9]; const float* k_norm_g = args.in[10]; const float* sinks = args.in[11];
    const float* rel_bias = args.in[12]; const float* w_bh = args.in[13]; const float* w_ba = args.in[14]; const float* w_out = args.in[15];
    const float* w_ff1 = args.in[16]; const float* w_ff2 = args.in[17];
    float* out = args.out;
    float* ADA = (float*)(ws + WS_ADA); float* LB = (float*)(ws + WS_LB); float* BT = (float*)(ws + WS_BT);
    bf16* WIN = (bf16*)(ws + WS_WIN); bf16* WBH = (bf16*)(ws + WS_WBH); bf16* WBA = (bf16*)(ws + WS_WBA); bf16* WOUT = (bf16*)(ws + WS_WOUT); bf16* WFF1 = (bf16*)(ws + WS_WFF1); bf16* WFF2 = (bf16*)(ws + WS_WFF2);
    unsigned char* ar = ws + WS_ARENA;
    bf16* QH = (bf16*)(ar + AO_QH); float* LOGF = (float*)(ar + AO_LOGF); bf16* VH = (bf16*)(ar + AO_VH); bf16* GH = (bf16*)(ar + AO_GH);
    bf16* AQ = (bf16*)(ar + AO_AQ); bf16* AK = (bf16*)(ar + AO_AK); bf16* VT = (bf16*)(ar + AO_VT); bf16* GSCR = (bf16*)(ar + AO_GSCR);
    bf16* MERGED = (bf16*)(ar + AO_MERGED); bf16* HB = (bf16*)(ar + AO_H); bf16* XN2 = (bf16*)(ar + AO_XN2); bf16* D1 = (bf16*)(ar + AO_D1);
    bf16* XN = (bf16*)(ar + AO_XN); bf16* OHG = (bf16*)out; bf16* OAT = (bf16*)((char*)out + 4 * MiB); bf16* QC = (bf16*)((char*)out + 8 * MiB); bf16* OLOC = (bf16*)((char*)out + 12 * MiB);
    float* SLOC = (float*)(ar + AO_SLOC); float* BSEG = (float*)(ar + AO_BSEG);
    const int gw = vcu * NWAVES + wave, NGW = G * NWAVES;

    if (IN(0)) REP(0) {
        if (bx < 192) p0_ada(lds, c, w_ada, b_ada, ADA, bx, tid);
        else if (bx == 192) {
            for (int i = tid; i < 1024; i += 512) { const float l0 = lb_logits[i], l1 = lb_logits[1024 + i]; LB[i] = 1.0f / (1.0f + expf(l1 - l0)); }
            for (int i = tid; i < 16 * 128; i += 512) { const int h = i >> 7, n = i & 127;
                int bkt = n; if (n >= 16) { bkt = 16 + (int)(logf((float)n / 16.0f) / logf(8.0f) * 16.0f); bkt = bkt > 31 ? 31 : bkt; }
                BT[i] = rel_bias[bkt * 16 + h]; }
        }
        LAS float* scr = (LAS float*)(lds + wave * P0_SCR);
        constexpr int I_IN = (DM / 64) * (INW / 64);
        const DescWin dw{w_in, WIN};
        if (bx < 192) transpose_items(dw, (bx * NWAVES + wave) * 2, 1, (bx * NWAVES + wave) * 2 + 2, scr, lane);
        else transpose_items(dw, 3072 + (bx - 192) * NWAVES + wave, 512, I_IN, scr, lane);
        SEAM(0);
    }
    if (IN(1)) REP(1) {
        norm_rows<false>(x, nullptr, norm1_g, ADA + 0 * DM, ADA + 1 * DM, lay::boff(XN, (size_t)(bx & 7) * lay::X8), bx, wave, lane);
        SEAM(1);
    }
    if (IN(2)) REP(2) {
        pg8::Gemm g{XN, XN, WIN, WIN, DM, lay::X8, lay::X8}; pg8::StaticOrder S; S.init(M, INW - 2 * DM, G, bx, P2_WGM);
        pg8::EpiProj E{QH, VH, GH, AQ, AK, VT, GSCR, GSCR, LOGF, LB};
        pg8::gemm_phase<pg8::EpiProj, pg8::StaticOrder, GEMM_ALIGN, GEMM_SP2>(lds + RING_OFF, g, S, E);
        if (bx >= 128) {
            LAS float* scr = (LAS float*)(lds + wave * P0_SCR);
            const DescRest dr{w_bh, w_ba, w_out, w_ff1, w_ff2, WBH, WBA, WOUT, WFF1, WFF2};
            transpose_items(dr, (bx - 128) * NWAVES + wave, 128 * NWAVES, DescRest::NITEMS, scr, lane);
        }
        SEAM(2);
    }
    const int xb = bx & 7, xi = bx >> 3;
    if (IN(3)) REP(3) {
        const size_t xbs = (size_t)xb;
        hg::hgrn_seg(lds, xb * 8 + (xi >> 2), xi & 3, lay::boff(QH, xbs * lay::X4), lay::boff(LOGF, xbs * lay::X8), lay::boff(VH, xbs * lay::X4), lay::boff(OLOC, xbs * lay::D4), lay::boff(QC, xbs * lay::D4), lay::boff(SLOC, xbs * lay::X2), lay::boff(BSEG, xbs * lay::XB));
        const bool split3 = BOTH(3) && REP_MASK == 0 && MK_N_LAUNCHES != N_PHASES && ((LOCAL_SEAMS >> 3) & 1) && canon == 1;
        unsigned tok3 = ~0u;
        if (split3) tok3 = xcd_barrier_local_arrive(bar);
        { LAS float* bt = (LAS float*)(lds + at::OFF_BT);
          static_assert(16 * at::BTS == 6 * 512, "bias table fill");
          float btv[6];
#pragma unroll
          for (int k = 0; k < 6; ++k) { const int i = tid + 512 * k, hd = i / at::BTS, e = i % at::BTS - 32; btv[k] = BT[hd * 128 + (e < 0 ? 0 : (e > 127 ? 127 : e))]; }
#pragma unroll
          for (int k = 0; k < 6; ++k) { const int i = tid + 512 * k, e = i % at::BTS - 32; bt[i] = (e >= 0 && e < 128) ? btv[k] * at::L2E : at::NEG; }
          if (tid < 64) ((LAS float*)(lds + at::OFF_QK))[tid] = q_norm_g[tid] * k_norm_g[tid] * (0.125f * at::L2E); }
        for (int e = 0; e < 2; ++e) at::attn_unit(lds, xb * 64 + xi * 2 + e, lay::boff(AQ, xbs * lay::X4), lay::boff(AK, xbs * lay::X1), lay::boff(VT, xbs * lay::X1), lay::boff(OAT, xbs * lay::D4), q_norm_g, k_norm_g, sinks);
        if (split3) xcd_barrier_local_wait(bar, tok3); else SEAM(3);
    }
    const bool split4 = BOTH(4) && REP_MASK == 0 && MK_N_LAUNCHES != N_PHASES && ((LOCAL_SEAMS >> 4) & 1) && canon == 1;
    unsigned tok4 = ~0u;
    if (IN(4)) REP(4) {
        const size_t xbs = (size_t)xb;
        hg::hgrn_fix(lds, xb * 8 + (xi >> 2), xi & 3, lay::boff(OLOC, xbs * lay::D4), lay::boff(QC, xbs * lay::D4), lay::boff(SLOC, xbs * lay::X2), lay::boff(BSEG, xbs * lay::XB), lay::boff(GH, xbs * lay::X4), hg_out_g, lay::boff(OHG, xbs * lay::D4));
        if (split4) tok4 = xcd_barrier_local_arrive(bar); else SEAM(4);
    }
    if (IN(5)) REP(5) {
        pg8::Gemm4 g{XN, OHG, OAT, WIN + (size_t)22 * 256 * DM, WIN + (size_t)30 * 256 * DM, WBH, WBA, DM, HGW, lay::X8, lay::D4, lay::D4};
        pg8::QuadOrder S; S.b.init(M, DM, G, bx, P56_WGM);
        pg8::EpiMerge4 E{lay::boff(GSCR, (size_t)xb * lay::AR + (size_t)xi * 262144), MERGED};
        auto hook4 = [&]() __attribute__((always_inline)) { if (split4) xcd_barrier_local_wait(bar, tok4); };
        pg8::gemm_phase<pg8::EpiMerge4, pg8::QuadOrder, GEMM_ALIGN, GEMM_SP2, true, true, pg8::Gemm4, decltype(hook4)>(lds + RING_OFF, g, S, E, hook4);
        SEAM(5);
    }
    if (IN(6)) REP(6) {
        pg8::Gemm g{MERGED, MERGED, WOUT, WOUT, DM, lay::X8, lay::X8}; pg8::StaticOrder S; S.init(M, DM, G, bx, P56_WGM);
        pg8::EpiDelta E{D1, ADA + 2 * DM, 12288};
        pg8::gemm_phase<pg8::EpiDelta, pg8::StaticOrder, GEMM_ALIGN, GEMM_SP2>(lds + RING_OFF, g, S, E);
        SEAM(6);
    }
    if (IN(7)) REP(7) {
        norm_rows<true>(x, lay::boff(D1, (size_t)(bx & 7) * lay::X8), norm2_g, ADA + 3 * DM, ADA + 4 * DM, lay::boff(XN2, (size_t)(bx & 7) * lay::X8), bx, wave, lane);
        SEAM(7);
    }
    if (IN(8)) REP(8) {
        pg8::Gemm g{XN2, XN2, WFF1, WFF1, DM, lay::X8, lay::X8}; pg8::StaticOrder S; S.init(M, DFF, G, bx, P8_WGM);
        pg8::EpiRelu2 E{HB, DFF};
        pg8::gemm_phase<pg8::EpiRelu2, pg8::StaticOrder, GEMM_ALIGN, GEMM_SP2>(lds + RING_OFF, g, S, E);
        SEAM(8);
    }
    if (IN(9)) {
        pg8::Gemm g{HB, HB, WFF2, WFF2, DFF, lay::X32, lay::X32}; pg8::StaticOrder S; S.init(M, DM, G, bx, P9_WGM);
        pg8::EpiResGate E{x, D1, out, ADA + 5 * DM, 12288};
        pg8::gemm_phase<pg8::EpiResGate, pg8::StaticOrder, GEMM_ALIGN, GEMM_SP2>(lds + RING_OFF, g, S, E);
    }
#undef IN
#undef BOTH
#undef GRID_BAR
#undef GRID_BAR_FULL
}

extern "C" void kernel_launch(void* const* d_in, const int* in_sizes, int n_in, void* d_out, int out_size, void* d_ws, size_t ws_size, hipStream_t stream) {
    static int grid = 0;
    if (grid == 0) {
        if (n_in != 18 || out_size != M * DM || ws_size < WS_END) { fprintf(stderr, "kernel_launch: unexpected shapes (n_in %d, out %d, ws %zu)\n", n_in, out_size, ws_size); grid = -1; return; }
        int dev = 0, cus = 0, per_cu = 0;
        if (hipGetDevice(&dev) != hipSuccess || hipDeviceGetAttribute(&cus, hipDeviceAttributeMultiprocessorCount, dev) != hipSuccess) { grid = -1; return; }
        if (hipFuncSetAttribute((const void*)hyb_fwd, hipFuncAttributeMaxDynamicSharedMemorySize, LDS_BYTES) != hipSuccess) { fprintf(stderr, "kernel_launch: hipFuncSetAttribute failed\n"); grid = -1; return; }
        if (hipOccupancyMaxActiveBlocksPerMultiprocessor(&per_cu, (const void*)hyb_fwd, NWAVES * 64, LDS_BYTES) != hipSuccess || per_cu < 1) { fprintf(stderr, "kernel_launch: occupancy query says %d\n", per_cu); per_cu = 1; }
        (void)hipGetLastError();
        if (cus < 256) { fprintf(stderr, "kernel_launch: %d CUs: this kernel needs 256 co-resident workgroups (one per CU); nothing launched\n", cus); grid = -1; return; }
        grid = 256;
    }
    if (grid < 0) return;
    (void)hipMemsetAsync((char*)d_ws + WS_CTL, 0, CTL_ZERO_BYTES, stream);
    Args a{};
    for (int i = 0; i < 18; ++i) a.in[i] = (const float*)d_in[i];
    a.out = (float*)d_out; a.ws = (unsigned char*)d_ws;
#ifndef PROBE_PHASE
#define PROBE_PHASE -1
#endif
    if (PROBE_PHASE >= 0) {
        a.ph_lo = 0; a.ph_hi = PROBE_PHASE + 1; a.li = 0;
        hipLaunchKernelGGL(hyb_fwd, dim3(grid), dim3(NWAVES * 64), LDS_BYTES, stream, a);
        a.ph_lo = PROBE_PHASE; a.ph_hi = N_PHASES; a.li = 1;
        hipLaunchKernelGGL(hyb_fwd, dim3(grid), dim3(NWAVES * 64), LDS_BYTES, stream, a);
    } else if (MK_N_LAUNCHES == 1) {
        a.ph_lo = 0; a.ph_hi = N_PHASES; a.li = 0;
        hipLaunchKernelGGL(hyb_fwd, dim3(grid), dim3(NWAVES * 64), LDS_BYTES, stream, a);
    } else {
        for (int li = 0; li < N_PHASES; ++li) { a.ph_lo = li; a.ph_hi = li + 1; a.li = 0;
            hipLaunchKernelGGL(hyb_fwd, dim3(grid), dim3(NWAVES * 64), LDS_BYTES, stream, a); }
    }
}
```

```cpp
#include <hip/hip_runtime.h>
#include <type_traits>
#include <cstdio>
#include <cstdint>

#ifndef GEMM_SP2
#define GEMM_SP2 true
#endif
#ifndef GEMM_ALIGN
#define GEMM_ALIGN true
#endif
#ifndef P2_WGM
#define P2_WGM 4
#endif
#ifndef P8_WGM
#define P8_WGM 8
#endif
#ifndef P56_WGM
#define P56_WGM 4
#endif
#ifndef P9_WGM
#define P9_WGM 4
#endif
#ifndef MK_N_LAUNCHES
#define MK_N_LAUNCHES 1
#endif

namespace lay {
constexpr size_t MiB = 1u << 20, AR = 48 * MiB, DR = 16 * MiB;
constexpr size_t X1 = AR - 1 * MiB, X2 = AR - 2 * MiB, X4 = AR - 4 * MiB, X8 = AR - 8 * MiB, X32 = AR - 32 * MiB, XB = AR - 16384;
constexpr size_t D4 = DR - 4 * MiB, D8 = DR - 8 * MiB;
template <class T> __device__ __forceinline__ T* boff(T* p, size_t bytes) { return (T*)((char*)p + bytes); }
template <class T> __device__ __forceinline__ const T* boff(const T* p, size_t bytes) { return (const T*)((const char*)p + bytes); }
}
namespace pg8 {
#define PG8_LAS __attribute__((address_space(3)))
typedef unsigned short bf16_t;
typedef short bf16x8 __attribute__((ext_vector_type(8)));
typedef float f32x4 __attribute__((ext_vector_type(4)));
typedef unsigned u32x4 __attribute__((ext_vector_type(4)));
typedef float f32x2 __attribute__((ext_vector_type(2)));
typedef __bf16 bf16x2_t __attribute__((ext_vector_type(2)));
constexpr int BM = 256, BK = 64, HALF = 128, HTB = HALF * BK * 2, STAGE_BYTES = 8 * HTB, NXCD = 8;

__host__ __device__ __forceinline__ int lds_byte(int r, int c) { const int st = (r >> 4) * 2 + (c >> 5), rr = r & 15, cc = c & 31, ob = rr * 64 + cc * 2; return st * 1024 + (ob ^ (((ob >> 9) & 1) << 5)); }
__host__ __device__ __forceinline__ void stage_rc(int b, int& R, int& C) { const int st = b / 1024, sb = b % 1024, swz = sb ^ (((sb >> 9) & 1) << 5); R = (st >> 1) * 16 + swz / 64; C = (st & 1) * 32 + (swz % 64) / 2; }
__host__ __device__ __forceinline__ int perm32(int rho) { const int n = rho >> 4, i = rho & 15; return 8 * (i >> 2) + 4 * n + (i & 3); }

__device__ __forceinline__ size_t blk_off(int row, int col, int nkt) { return ((size_t)(row >> 7) * nkt + (col >> 6)) * 16384 + lds_byte(row & 127, col & 63); }
struct Unit { int pm, pn, seg; };
struct Gemm { const bf16_t *A0, *A1, *B0, *B1; int K; size_t xa0, xa1;
    __device__ __forceinline__ const char* a(int seg, int pm) const { return (const char*)(seg ? A1 : A0) + (size_t)(pm >> 3) * (seg ? xa1 : xa0); }
    __device__ __forceinline__ const char* b(int seg) const { return (const char*)(seg ? B1 : B0); }
    __device__ __forceinline__ int nt(int) const { return K / BK; } };
struct Gemm4 { const bf16_t *Ag, *A2, *A3, *Bg0, *Bg1, *B2, *B3; int Kg, Kb; size_t xag, xa2, xa3;
    __device__ __forceinline__ const char* a(int seg, int pm) const { return (const char*)(seg < 2 ? Ag : (seg == 2 ? A2 : A3)) + (size_t)(pm >> 3) * (seg < 2 ? xag : (seg == 2 ? xa2 : xa3)); }
    __device__ __forceinline__ const char* b(int seg) const { return (const char*)(seg == 0 ? Bg0 : (seg == 1 ? Bg1 : (seg == 2 ? B2 : B3))); }
    __device__ __forceinline__ int nt(int seg) const { return (seg < 2 ? Kg : Kb) / BK; } };

struct StaticOrder {
    int nM, nN, nwg, G, c, WGM; bool flip;
    __device__ void init(int M, int N, int G_, int c_, int wgm = 8, bool flip_ = false) { nM = M / BM; nN = N / BM; nwg = nM * nN; G = G_; c = c_; WGM = wgm; flip = flip_; }
    __device__ bool tile(int i, Unit& u) const {
        const long L = (long)i * G + c; if (L >= nwg) return false;
        int wgid = (int)L; { const int q = nwg / NXCD, r = nwg % NXCD, xcd = wgid % NXCD, off = wgid / NXCD; wgid = (xcd < r ? xcd * (q + 1) : r * (q + 1) + (xcd - r) * q) + off; }
        const int nig = WGM * nN, gid = wgid / nig, fm = gid * WGM, gsz = (nM - fm) < WGM ? (nM - fm) : WGM;
        u.pm = fm + ((wgid % nig) % gsz); u.pn = (wgid % nig) / gsz; if (flip) u.pn = nN - 1 - u.pn; return true;
    }
    static constexpr int NSEG = 1;
    __device__ bool tl(int i, Unit& u) const { return tile(i, u); }
};
struct DualOrder {
    StaticOrder b;
    static constexpr int NSEG = 2;
    __device__ bool tl(int i, Unit& u) const { return b.tile(i, u); }
};
struct QuadOrder {
    StaticOrder b;
    static constexpr int NSEG = 4;
    __device__ bool tl(int i, Unit& u) const { return b.tile(i, u); }
};

__device__ __forceinline__ unsigned cvtpk(float lo, float hi) { f32x2 v = {lo, hi}; bf16x2_t b = __builtin_convertvector(v, bf16x2_t); return __builtin_bit_cast(unsigned, b); }
__device__ __forceinline__ float bflo(unsigned w) { return __uint_as_float(w << 16); }
__device__ __forceinline__ float bfhi(unsigned w) { return __uint_as_float(w & 0xffff0000u); }
__device__ __forceinline__ float fast_exp(float x) { return __builtin_amdgcn_exp2f(x * 1.4426950408889634f); }
__device__ __forceinline__ float sigmoidf_(float x) { return __builtin_amdgcn_rcpf(1.0f + fast_exp(-x)); }


struct EpiProj {
    static constexpr bool PERM = true;
    bf16_t *QH, *VH, *GH, *AQ, *AK, *VT, *GHG, *GAT; float* LOGF; const float* lb;
    __device__ __forceinline__ bool operator()(const f32x4 (&acc)[2][2][4][2], const Unit& u, int wr, int wc, int fr, int fq) const {
        const int pn = u.pn; const int row0 = u.pm * BM + wr * 64 + fr; const int cin = wc * 32 + 8 * fq;
        const size_t bb = (size_t)(u.pm >> 3);
        int mode, ldc, colt; bf16_t* base;
        if (pn < 4) { mode = 1; base = lay::boff(QH, bb * lay::X4); ldc = 1024; colt = pn * 256; }
        else if (pn < 8) { mode = 3; base = nullptr; ldc = 1024; colt = (pn - 4) * 256; }
        else if (pn < 12) { mode = 0; base = lay::boff(VH, bb * lay::X4); ldc = 1024; colt = (pn - 8) * 256; }
        else if (pn < 16) { mode = 1; base = lay::boff(GH, bb * lay::X4); ldc = 1024; colt = (pn - 12) * 256; }
        else if (pn < 20) { mode = 0; base = lay::boff(AQ, bb * lay::X4); ldc = 1024; colt = (pn - 16) * 256; }
        else if (pn == 20) { mode = 0; base = lay::boff(AK, bb * lay::X1); ldc = 256; colt = 0; }
        else if (pn == 21) { mode = 4; base = lay::boff(VT, bb * lay::X1); ldc = 0; colt = 0; }
        else if (pn < 30) { mode = 2; base = lay::boff(GHG, bb * lay::X8); ldc = 2048; colt = (pn - 22) * 256; }
        else { mode = 2; base = lay::boff(GAT, bb * lay::X8); ldc = 2048; colt = (pn - 30) * 256; }
        const int col0 = colt + cin;
        if (mode == 3) {
            f32x4 l0[2], l1[2];
#pragma unroll
            for (int bj = 0; bj < 2; ++bj) { l0[bj] = *(const f32x4*)(lb + col0 + bj * HALF); l1[bj] = *(const f32x4*)(lb + col0 + bj * HALF + 4); }
#pragma unroll
            for (int ai = 0; ai < 2; ++ai)
#pragma unroll
                for (int m = 0; m < 4; ++m) { float* rowp = lay::boff(LOGF, bb * lay::X8) + (size_t)(row0 + ai * HALF + m * 16) * 1024 + col0;
#pragma unroll
                    for (int bj = 0; bj < 2; ++bj) { const f32x4 v0 = acc[ai][bj][m][0], v1 = acc[ai][bj][m][1]; f32x4 o0, o1;
#pragma unroll
                        for (int e = 0; e < 4; ++e) { const float s0 = sigmoidf_(v0[e]), s1 = sigmoidf_(v1[e]);
                            o0[e] = __logf(l0[bj][e] + (1.0f - l0[bj][e]) * s0); o1[e] = __logf(l1[bj][e] + (1.0f - l1[bj][e]) * s1); }
                        *(f32x4*)(rowp + bj * HALF) = o0; *(f32x4*)(rowp + bj * HALF + 4) = o1; } }
            return false;
        }
        if (mode == 4) {
#pragma unroll
            for (int ai = 0; ai < 2; ++ai)
#pragma unroll
                for (int m = 0; m < 4; ++m) { const int row = row0 + ai * HALF + m * 16; const int b = row >> 11, t = row & 2047;
#pragma unroll
                    for (int bj = 0; bj < 2; ++bj) { const f32x4 v0 = acc[ai][bj][m][0], v1 = acc[ai][bj][m][1]; const int c = col0 + bj * HALF;
                        bf16_t* p = base + ((size_t)(b * 256 + c)) * 2048 + t;
                        const unsigned w0 = cvtpk(v0[0], v0[1]), w1 = cvtpk(v0[2], v0[3]), w2 = cvtpk(v1[0], v1[1]), w3 = cvtpk(v1[2], v1[3]);
                        p[0] = (bf16_t)w0; p[2048] = (bf16_t)(w0 >> 16); p[2 * 2048] = (bf16_t)w1; p[3 * 2048] = (bf16_t)(w1 >> 16);
                        p[4 * 2048] = (bf16_t)w2; p[5 * 2048] = (bf16_t)(w2 >> 16); p[6 * 2048] = (bf16_t)w3; p[7 * 2048] = (bf16_t)(w3 >> 16); } }
            return false;
        }
#pragma unroll
        for (int ai = 0; ai < 2; ++ai)
#pragma unroll
            for (int m = 0; m < 4; ++m) { bf16_t* rowp = base + (size_t)(row0 + ai * HALF + m * 16) * ldc + col0;
#pragma unroll
                for (int bj = 0; bj < 2; ++bj) { f32x4 v0 = acc[ai][bj][m][0], v1 = acc[ai][bj][m][1];
                    if (mode != 0) {
#pragma unroll
                        for (int e = 0; e < 4; ++e) { const float s0 = sigmoidf_(v0[e]), s1 = sigmoidf_(v1[e]); v0[e] = (mode == 1) ? v0[e] * s0 : s0; v1[e] = (mode == 1) ? v1[e] * s1 : s1; } }
                    u32x4 w; w.x = cvtpk(v0[0], v0[1]); w.y = cvtpk(v0[2], v0[3]); w.z = cvtpk(v1[0], v1[1]); w.w = cvtpk(v1[2], v1[3]);
                    *(u32x4*)(rowp + bj * HALF) = w; } }
        return false;
    }
};

struct EpiMerge {
    static constexpr bool PERM = true;
    const bf16_t *GHG, *GAT; bf16_t* OUT;
    __device__ __forceinline__ bool operator()(f32x4 (&acc)[2][2][4][2], const Unit& u, int wr, int wc, int fr, int fq) const {
        const int row0 = u.pm * BM + wr * 64 + fr, col0 = u.pn * BM + wc * 32 + 8 * fq;
        const bf16_t* GHG = lay::boff(this->GHG, (size_t)(u.pm >> 3) * lay::X8); const bf16_t* GAT = lay::boff(this->GAT, (size_t)(u.pm >> 3) * lay::X8); bf16_t* OUT = lay::boff(this->OUT, (size_t)(u.pm >> 3) * lay::X8);
        if (u.seg == 0) {
#pragma unroll
            for (int ai = 0; ai < 2; ++ai)
#pragma unroll
                for (int m = 0; m < 4; ++m) { const size_t off = (size_t)(row0 + ai * HALF + m * 16) * 2048 + col0;
#pragma unroll
                    for (int bj = 0; bj < 2; ++bj) {
                        const u32x4 ga = *(const u32x4*)(GAT + off + bj * HALF); const u32x4 gh = *(const u32x4*)(GHG + off + bj * HALF);
                        f32x4 r0, r1;
                        r0[0] = bflo(gh.x) * __builtin_amdgcn_rcpf(bflo(ga.x)); r0[1] = bfhi(gh.x) * __builtin_amdgcn_rcpf(bfhi(ga.x));
                        r0[2] = bflo(gh.y) * __builtin_amdgcn_rcpf(bflo(ga.y)); r0[3] = bfhi(gh.y) * __builtin_amdgcn_rcpf(bfhi(ga.y));
                        r1[0] = bflo(gh.z) * __builtin_amdgcn_rcpf(bflo(ga.z)); r1[1] = bfhi(gh.z) * __builtin_amdgcn_rcpf(bfhi(ga.z));
                        r1[2] = bflo(gh.w) * __builtin_amdgcn_rcpf(bflo(ga.w)); r1[3] = bfhi(gh.w) * __builtin_amdgcn_rcpf(bfhi(ga.w));
                        acc[ai][bj][m][0] *= r0; acc[ai][bj][m][1] *= r1; } }
            return true;
        }
#pragma unroll
        for (int ai = 0; ai < 2; ++ai)
#pragma unroll
            for (int m = 0; m < 4; ++m) { const size_t off = (size_t)(row0 + ai * HALF + m * 16) * 2048 + col0;
#pragma unroll
                for (int bj = 0; bj < 2; ++bj) {
                    const u32x4 ga = *(const u32x4*)(GAT + off + bj * HALF);
                    const f32x4 v0 = acc[ai][bj][m][0], v1 = acc[ai][bj][m][1];
                    u32x4 w; w.x = cvtpk(v0[0] * bflo(ga.x), v0[1] * bfhi(ga.x)); w.y = cvtpk(v0[2] * bflo(ga.y), v0[3] * bfhi(ga.y));
                    w.z = cvtpk(v1[0] * bflo(ga.z), v1[1] * bfhi(ga.z)); w.w = cvtpk(v1[2] * bflo(ga.w), v1[3] * bfhi(ga.w));
                    *(u32x4*)((char*)OUT + blk_off(row0 + ai * HALF + m * 16, col0 + bj * HALF, 2048 / 64)) = w; } }
        return false;
    }
};

struct EpiResGate {
    static constexpr bool PERM = true;
    const float* base; const bf16_t* delta; float* out; const float* gate; int gstride;
    __device__ __forceinline__ bool operator()(const f32x4 (&acc)[2][2][4][2], const Unit& u, int wr, int wc, int fr, int fq) const {
        const int row0 = u.pm * BM + wr * 64 + fr, col0 = u.pn * BM + wc * 32 + 8 * fq;
        const float* gp = gate + (size_t)(row0 >> 11) * gstride + col0;
        const bf16_t* delta = lay::boff(this->delta, (size_t)(u.pm >> 3) * lay::X8);
        f32x4 g0[2], g1[2];
#pragma unroll
        for (int bj = 0; bj < 2; ++bj) { g0[bj] = *(const f32x4*)(gp + bj * HALF); g1[bj] = *(const f32x4*)(gp + bj * HALF + 4); }
#ifndef EPI9_PF
#define EPI9_PF 1
#endif
        f32x4 xb0[2][2][2], xb1[2][2][2]; u32x4 xd[2][2][2];
        auto ld = [&](int k, int s) __attribute__((always_inline)) {
#pragma unroll
            for (int mm = 0; mm < 2; ++mm) { const size_t off = (size_t)(row0 + (k >> 1) * HALF + ((k & 1) * 2 + mm) * 16) * 2048 + col0;
#pragma unroll
                for (int bj = 0; bj < 2; ++bj) { xb0[s][mm][bj] = __builtin_nontemporal_load((const f32x4*)(base + off + bj * HALF)); xb1[s][mm][bj] = __builtin_nontemporal_load((const f32x4*)(base + off + bj * HALF + 4));
                    xd[s][mm][bj] = *(const u32x4*)(delta + off + bj * HALF); } } };
        auto cs = [&](int k, int s) __attribute__((always_inline)) {
#pragma unroll
            for (int mm = 0; mm < 2; ++mm) { const int ai = k >> 1, m = (k & 1) * 2 + mm; const size_t off = (size_t)(row0 + ai * HALF + m * 16) * 2048 + col0;
#pragma unroll
                for (int bj = 0; bj < 2; ++bj) { const u32x4 dv = xd[s][mm][bj];
                    const f32x4 d0 = (f32x4){bflo(dv.x), bfhi(dv.x), bflo(dv.y), bfhi(dv.y)}, d1 = (f32x4){bflo(dv.z), bfhi(dv.z), bflo(dv.w), bfhi(dv.w)};
                    *(f32x4*)(out + off + bj * HALF) = (xb0[s][mm][bj] + d0) + g0[bj] * acc[ai][bj][m][0]; *(f32x4*)(out + off + bj * HALF + 4) = (xb1[s][mm][bj] + d1) + g1[bj] * acc[ai][bj][m][1]; } } };
#define SB9 __builtin_amdgcn_sched_barrier(0)
        if (EPI9_PF == 0) { ld(0, 0); SB9; cs(0, 0); SB9; ld(1, 0); SB9; cs(1, 0); SB9; ld(2, 0); SB9; cs(2, 0); SB9; ld(3, 0); SB9; cs(3, 0); SB9; }
        else {
            ld(0, 0); SB9; cs(0, 0); SB9; ld(1, 1); ld(2, 0); SB9; cs(1, 1); SB9; ld(3, 1); SB9; cs(2, 0); SB9; cs(3, 1); SB9; }
#undef SB9
        return false;
    }
};

struct EpiMerge4 {
    static constexpr bool PERM = true;
    bf16_t* SCR; bf16_t* OUT;
    __device__ __forceinline__ bool operator()(f32x4 (&acc)[2][2][4][2], const Unit& u, int wr, int wc, int fr, int fq) const {
        const int row0 = u.pm * BM + wr * 64 + fr, col0 = u.pn * BM + wc * 32 + 8 * fq;
        unsigned zo = 0; asm volatile("" : "+v"(zo));
        u32x4* sc = (u32x4*)((char*)SCR + zo) + (wr * 4 + wc) * 64 + fq * 16 + fr;
        if (u.seg < 2) {
            u32x4* dst = sc + u.seg * 8192;
#pragma unroll
            for (int ai = 0; ai < 2; ++ai)
#pragma unroll
                for (int m = 0; m < 4; ++m)
#pragma unroll
                    for (int bj = 0; bj < 2; ++bj) { f32x4 v0 = acc[ai][bj][m][0], v1 = acc[ai][bj][m][1];
#pragma unroll
                        for (int e = 0; e < 4; ++e) { v0[e] = sigmoidf_(v0[e]); v1[e] = sigmoidf_(v1[e]); }
                        u32x4 w; w.x = cvtpk(v0[0], v0[1]); w.y = cvtpk(v0[2], v0[3]); w.z = cvtpk(v1[0], v1[1]); w.w = cvtpk(v1[2], v1[3]);
                        dst[((ai * 4 + m) * 2 + bj) * 512] = w; }
            return false;
        }
        if (u.seg == 2) {
#pragma unroll
            for (int ai = 0; ai < 2; ++ai) {
                u32x4 gh[4][2], ga[4][2];
#pragma unroll
                for (int m = 0; m < 4; ++m)
#pragma unroll
                    for (int bj = 0; bj < 2; ++bj) { const int pc = ((ai * 4 + m) * 2 + bj) * 512; gh[m][bj] = sc[pc]; ga[m][bj] = sc[8192 + pc]; }
#pragma unroll
                for (int m = 0; m < 4; ++m)
#pragma unroll
                    for (int bj = 0; bj < 2; ++bj) { const u32x4 h = gh[m][bj], a = ga[m][bj];
                        f32x4 r0, r1;
                        r0[0] = bflo(h.x) * __builtin_amdgcn_rcpf(bflo(a.x)); r0[1] = bfhi(h.x) * __builtin_amdgcn_rcpf(bfhi(a.x));
                        r0[2] = bflo(h.y) * __builtin_amdgcn_rcpf(bflo(a.y)); r0[3] = bfhi(h.y) * __builtin_amdgcn_rcpf(bfhi(a.y));
                        r1[0] = bflo(h.z) * __builtin_amdgcn_rcpf(bflo(a.z)); r1[1] = bfhi(h.z) * __builtin_amdgcn_rcpf(bfhi(a.z));
                        r1[2] = bflo(h.w) * __builtin_amdgcn_rcpf(bflo(a.w)); r1[3] = bfhi(h.w) * __builtin_amdgcn_rcpf(bfhi(a.w));
                        acc[ai][bj][m][0] *= r0; acc[ai][bj][m][1] *= r1; }
                asm volatile("" : "+v"(acc[ai][0][0][0]), "+v"(acc[ai][0][0][1]), "+v"(acc[ai][0][1][0]), "+v"(acc[ai][0][1][1]), "+v"(acc[ai][0][2][0]), "+v"(acc[ai][0][2][1]), "+v"(acc[ai][0][3][0]), "+v"(acc[ai][0][3][1]),
                                  "+v"(acc[ai][1][0][0]), "+v"(acc[ai][1][0][1]), "+v"(acc[ai][1][1][0]), "+v"(acc[ai][1][1][1]), "+v"(acc[ai][1][2][0]), "+v"(acc[ai][1][2][1]), "+v"(acc[ai][1][3][0]), "+v"(acc[ai][1][3][1]) :: "memory");
            }
            return true;
        }
        char* outb = (char*)OUT + (size_t)(u.pm >> 3) * lay::X8;
        u32x4 gav[2][4][2];
#pragma unroll
        for (int ai = 0; ai < 2; ++ai)
#pragma unroll
            for (int m = 0; m < 4; ++m)
#pragma unroll
                for (int bj = 0; bj < 2; ++bj) gav[ai][m][bj] = sc[8192 + ((ai * 4 + m) * 2 + bj) * 512];
        __builtin_amdgcn_sched_barrier(0);
#pragma unroll
        for (int ai = 0; ai < 2; ++ai)
#pragma unroll
            for (int m = 0; m < 4; ++m)
#pragma unroll
                for (int bj = 0; bj < 2; ++bj) { const u32x4 ga = gav[ai][m][bj];
                    const f32x4 v0 = acc[ai][bj][m][0], v1 = acc[ai][bj][m][1];
                    u32x4 w; w.x = cvtpk(v0[0] * bflo(ga.x), v0[1] * bfhi(ga.x)); w.y = cvtpk(v0[2] * bflo(ga.y), v0[3] * bfhi(ga.y));
                    w.z = cvtpk(v1[0] * bflo(ga.z), v1[1] * bfhi(ga.z)); w.w = cvtpk(v1[2] * bflo(ga.w), v1[3] * bfhi(ga.w));
                    *(u32x4*)(outb + blk_off(row0 + ai * HALF + m * 16, col0 + bj * HALF, 2048 / 64)) = w; }
        __builtin_amdgcn_sched_barrier(0);
        return false;
    }
};

struct EpiDelta {
    static constexpr bool PERM = true;
    bf16_t* O; const float* gate; int gstride;
    __device__ __forceinline__ bool operator()(const f32x4 (&acc)[2][2][4][2], const Unit& u, int wr, int wc, int fr, int fq) const {
        const int row0 = u.pm * BM + wr * 64 + fr, col0 = u.pn * BM + wc * 32 + 8 * fq;
        const float* gp = gate + (size_t)(row0 >> 11) * gstride + col0;
        f32x4 g0[2], g1[2];
#pragma unroll
        for (int bj = 0; bj < 2; ++bj) { g0[bj] = *(const f32x4*)(gp + bj * HALF); g1[bj] = *(const f32x4*)(gp + bj * HALF + 4); }
#pragma unroll
        for (int ai = 0; ai < 2; ++ai)
#pragma unroll
            for (int m = 0; m < 4; ++m) { bf16_t* rowp = lay::boff(O, (size_t)(u.pm >> 3) * lay::X8) + (size_t)(row0 + ai * HALF + m * 16) * 2048 + col0;
#pragma unroll
                for (int bj = 0; bj < 2; ++bj) { const f32x4 v0 = acc[ai][bj][m][0] * g0[bj], v1 = acc[ai][bj][m][1] * g1[bj];
                    u32x4 w; w.x = cvtpk(v0[0], v0[1]); w.y = cvtpk(v0[2], v0[3]); w.z = cvtpk(v1[0], v1[1]); w.w = cvtpk(v1[2], v1[3]);
                    *(u32x4*)(rowp + bj * HALF) = w; } }
        return false;
    }
};

struct EpiRelu2 {
    static constexpr bool PERM = true;
    bf16_t* O; int ldc;
    __device__ __forceinline__ bool operator()(const f32x4 (&acc)[2][2][4][2], const Unit& u, int wr, int wc, int fr, int fq) const {
        const int row0 = u.pm * BM + wr * 64 + fr, col0 = u.pn * BM + wc * 32 + 8 * fq;
#pragma unroll
        for (int ai = 0; ai < 2; ++ai)
#pragma unroll
            for (int m = 0; m < 4; ++m) { const int row = row0 + ai * HALF + m * 16;
#pragma unroll
                for (int bj = 0; bj < 2; ++bj) { f32x4 v0 = acc[ai][bj][m][0], v1 = acc[ai][bj][m][1];
#pragma unroll
                    for (int e = 0; e < 4; ++e) { const float r0 = fmaxf(v0[e], 0.f), r1 = fmaxf(v1[e], 0.f); v0[e] = r0 * r0; v1[e] = r1 * r1; }
                    u32x4 w; w.x = cvtpk(v0[0], v0[1]); w.y = cvtpk(v0[2], v0[3]); w.z = cvtpk(v1[0], v1[1]); w.w = cvtpk(v1[2], v1[3]);
                    __builtin_nontemporal_store(w, (u32x4*)((char*)O + (size_t)(u.pm >> 3) * lay::X32 + blk_off(row, col0 + bj * HALF, ldc / 64))); } }
        return false;
    }
};

template <class Epi, class Sched, bool ALIGN_EPI = false, bool SP2 = false, bool BLKB = true, bool BLKA = true, class GemmT = Gemm>
__device__ __forceinline__ void gemm_phase(PG8_LAS unsigned char* lds, const GemmT g, const Sched& S, const Epi& E) {
    const int tid = threadIdx.x, wid = __builtin_amdgcn_readfirstlane(tid >> 6), lane = tid & 63, wr = wid >> 2, wc = wid & 3, fr = lane & 15, fq = lane >> 4;
    static_assert(BLKA && BLKB, "operands are stored in LDS-image order");
    unsigned voffA[2], voffB[2];
#pragma unroll
    for (int i = 0; i < 2; ++i) { int R, C; stage_rc(tid * 16 + i * 8192, R, C); const int Rb = Epi::PERM ? ((R & ~31) + perm32(R & 31)) : R;
        (void)R; (void)C; (void)Rb; voffA[i] = (unsigned)(tid * 16 + i * 8192); voffB[i] = (unsigned)(tid * 16 + i * 8192); }
    const size_t kstep = BLKA ? (size_t)16384 : (size_t)(BK * 2);
    const size_t kstepB = BLKB ? (size_t)16384 : (size_t)(BK * 2);
    const unsigned ldsw = (unsigned)wid * 1024u;
    const int aoff = lds_byte(wr * 64 + fr, fq * 8), boff = lds_byte(wc * 32 + fr, fq * 8);
#define PG8_SA(b, h) (((b) * 2 + (h)) * HTB)
#define PG8_SB(b, h) ((4 + (b) * 2 + (h)) * HTB)
#define PG8_STAGE(bufoff, gbase, voff) do { _Pragma("unroll") for (int _i = 0; _i < 2; ++_i) \
        __builtin_amdgcn_global_load_lds((const unsigned*)((const char*)(gbase) + (voff)[_i]), (PG8_LAS unsigned*)(lds + (bufoff) + ldsw + _i * 8192), 16, 0, 0); } while (0)
#define PG8_LDA(dst, b, h) do { _Pragma("unroll") for (int m = 0; m < 4; ++m) _Pragma("unroll") for (int k = 0; k < 2; ++k) dst[m][k] = *(const PG8_LAS bf16x8*)(lds + PG8_SA(b, h) + aoff + m * 2048 + k * 1024); } while (0)
#define PG8_LDB(dst, b, h) do { _Pragma("unroll") for (int n = 0; n < 2; ++n) _Pragma("unroll") for (int k = 0; k < 2; ++k) dst[n][k] = *(const PG8_LAS bf16x8*)(lds + PG8_SB(b, h) + boff + n * 2048 + k * 1024); } while (0)
#define PG8_MMA(ai, bj, At, Bt) do { __builtin_amdgcn_s_setprio(1); _Pragma("unroll") for (int m = 0; m < 4; ++m) _Pragma("unroll") for (int n = 0; n < 2; ++n) _Pragma("unroll") for (int k = 0; k < 2; ++k) \
        acc[ai][bj][m][n] = __builtin_amdgcn_mfma_f32_16x16x32_bf16(Bt[n][k], At[m][k], acc[ai][bj][m][n], 0, 0, 0); __builtin_amdgcn_s_setprio(0); } while (0)
#define PG8_WAIT_V(n) asm volatile("s_waitcnt vmcnt(" #n ")" ::: "memory")
#define PG8_WAIT_L(n) asm volatile("s_waitcnt lgkmcnt(" #n ")" ::: "memory")
#define PG8_BAR __builtin_amdgcn_s_barrier()
#define PG8_SCHED __builtin_amdgcn_sched_barrier(0)
    Unit cur, nxt; int ti = 0;
    if (!S.tl(0, cur)) return;
    cur.seg = 0;
    f32x4 acc[2][2][4][2];
#pragma unroll
    for (int a = 0; a < 2; ++a)
#pragma unroll
        for (int b = 0; b < 2; ++b)
#pragma unroll
            for (int m = 0; m < 4; ++m)
#pragma unroll
                for (int n = 0; n < 2; ++n) acc[a][b][m][n] = (f32x4){0.f, 0.f, 0.f, 0.f};
    bf16x8 At[4][2], B0[2][2], B1[2][2];
    const char* cA; const char* cB;
    { const size_t hstep = (size_t)g.nt(0) * 16384;
    cA = g.a(0, cur.pm) + (size_t)cur.pm * (2 * hstep); cB = g.b(0) + (size_t)cur.pn * (2 * hstep);
    if constexpr (SP2) {
        PG8_STAGE(PG8_SB(0, 0), cB, voffB); PG8_STAGE(PG8_SB(0, 1), cB + hstep, voffB); PG8_STAGE(PG8_SA(0, 0), cA, voffA); PG8_STAGE(PG8_SA(0, 1), cA + hstep, voffA);
        if (wr == 1) PG8_BAR;
        PG8_WAIT_V(2); PG8_BAR;
        PG8_STAGE(PG8_SB(1, 0), cB + kstepB, voffB); PG8_STAGE(PG8_SA(1, 0), cA + kstep, voffA); PG8_STAGE(PG8_SB(1, 1), cB + hstep + kstepB, voffB);
        PG8_WAIT_V(6); PG8_BAR;
    } else {
        PG8_STAGE(PG8_SB(0, 0), cB, voffB); PG8_STAGE(PG8_SA(0, 0), cA, voffA); PG8_STAGE(PG8_SB(0, 1), cB + hstep, voffB); PG8_STAGE(PG8_SA(0, 1), cA + hstep, voffA);
        if (wr == 1) PG8_BAR;
        PG8_WAIT_V(4); PG8_BAR;
        PG8_STAGE(PG8_SB(1, 0), cB + kstepB, voffB); PG8_STAGE(PG8_SA(1, 0), cA + kstep, voffA); PG8_STAGE(PG8_SB(1, 1), cB + hstep + kstepB, voffB);
        PG8_WAIT_V(6); PG8_BAR;
    } }
    auto unit = [&](auto segc) __attribute__((always_inline)) -> bool {
        constexpr int SEG = decltype(segc)::value, NXS = (SEG + 1) % Sched::NSEG;
        bool has_next = true;
        if constexpr (SEG + 1 < Sched::NSEG) nxt = cur; else has_next = S.tl(ti + 1, nxt);
        const int nt = g.nt(SEG), nnt = g.nt(NXS); const size_t hstep = (size_t)nt * 16384, nhstep = (size_t)nnt * 16384;
        const char* nA = has_next ? g.a(NXS, nxt.pm) + (size_t)nxt.pm * (2 * nhstep) : cA; const char* nB = has_next ? g.b(NXS) + (size_t)nxt.pn * (2 * nhstep) : cB;
        for (int t = 0; t < nt; t += 2) {
            const bool last = (t == nt - 2);
            const char* a1 = cA + (size_t)(t + 1) * kstep;
            const char* a2 = last ? nA : cA + (size_t)(t + 2) * kstep; const char* b2 = last ? nB : cB + (size_t)(t + 2) * kstepB;
            const char* a3 = a2 + kstep; const char* b3 = b2 + kstepB;
            const size_t h2 = last ? nhstep : hstep;
            if constexpr (SP2) {
            PG8_LDB(B0, 0, 0); PG8_LDB(B1, 0, 1); PG8_SCHED; PG8_LDA(At, 0, 0); PG8_STAGE(PG8_SA(1, 1), a1 + hstep, voffA);
            PG8_WAIT_V(8); PG8_WAIT_L(0); PG8_BAR; PG8_MMA(0, 0, At, B0); PG8_MMA(0, 1, At, B1); PG8_BAR; PG8_SCHED;
            PG8_LDA(At, 0, 1); PG8_STAGE(PG8_SB(0, 0), b2, voffB); PG8_STAGE(PG8_SB(0, 1), b2 + h2, voffB); PG8_STAGE(PG8_SA(0, 0), a2, voffA);
            PG8_WAIT_V(8); PG8_WAIT_L(0); PG8_BAR; PG8_MMA(1, 0, At, B0); PG8_MMA(1, 1, At, B1); PG8_BAR; PG8_SCHED;
            PG8_LDB(B0, 1, 0); PG8_LDB(B1, 1, 1); PG8_SCHED; PG8_LDA(At, 1, 0); PG8_STAGE(PG8_SA(0, 1), a2 + h2, voffA);
            PG8_WAIT_V(8); PG8_WAIT_L(0); PG8_BAR; PG8_MMA(0, 0, At, B0); PG8_MMA(0, 1, At, B1); PG8_BAR; PG8_SCHED;
            PG8_LDA(At, 1, 1); PG8_STAGE(PG8_SB(1, 0), b3, voffB); PG8_STAGE(PG8_SB(1, 1), b3 + h2, voffB); PG8_STAGE(PG8_SA(1, 0), a3, voffA);
            PG8_WAIT_V(8); PG8_WAIT_L(0); PG8_BAR; PG8_MMA(1, 0, At, B0); PG8_MMA(1, 1, At, B1); PG8_BAR; PG8_SCHED;
            } else {
            PG8_LDB(B0, 0, 0); PG8_SCHED; PG8_LDA(At, 0, 0); PG8_STAGE(PG8_SA(1, 1), a1 + hstep, voffA);
            PG8_WAIT_L(8); PG8_BAR; PG8_WAIT_L(0); PG8_MMA(0, 0, At, B0); PG8_BAR; PG8_SCHED;
            PG8_LDB(B1, 0, 1); PG8_STAGE(PG8_SB(0, 0), b2, voffB);
            PG8_BAR; PG8_WAIT_L(0); PG8_MMA(0, 1, At, B1); PG8_BAR;
            PG8_LDA(At, 0, 1); PG8_STAGE(PG8_SA(0, 0), a2, voffA);
            PG8_BAR; PG8_WAIT_L(0); PG8_MMA(1, 0, At, B0); PG8_BAR; PG8_SCHED;
            PG8_STAGE(PG8_SB(0, 1), b2 + h2, voffB);
            PG8_WAIT_V(6); PG8_BAR; PG8_MMA(1, 1, At, B1); PG8_BAR;
            PG8_LDB(B0, 1, 0); PG8_SCHED; PG8_LDA(At, 1, 0); PG8_STAGE(PG8_SA(0, 1), a2 + h2, voffA);
            PG8_WAIT_L(8); PG8_BAR; PG8_WAIT_L(0); PG8_MMA(0, 0, At, B0); PG8_BAR; PG8_SCHED;
            PG8_LDB(B1, 1, 1); PG8_STAGE(PG8_SB(1, 0), b3, voffB);
            PG8_BAR; PG8_WAIT_L(0); PG8_MMA(0, 1, At, B1); PG8_BAR;
            PG8_LDA(At, 1, 1); PG8_STAGE(PG8_SA(1, 0), a3, voffA);
            PG8_BAR; PG8_WAIT_L(0); PG8_MMA(1, 0, At, B0); PG8_BAR; PG8_SCHED;
            PG8_STAGE(PG8_SB(1, 1), b3 + h2, voffB);
            PG8_WAIT_V(6); PG8_BAR; PG8_MMA(1, 1, At, B1); PG8_BAR;
            }
        }
        if constexpr (ALIGN_EPI) { if (wr == 0) PG8_BAR; }
        Unit u = cur; u.seg = SEG;
        const bool keep = E(acc, u, wr, wc, fr, fq);
        if (!has_next) return false;
        if (!keep) {
#pragma unroll
        for (int a = 0; a < 2; ++a)
#pragma unroll
            for (int b = 0; b < 2; ++b)
#pragma unroll
                for (int m = 0; m < 4; ++m)
#pragma unroll
                    for (int n = 0; n < 2; ++n) acc[a][b][m][n] = (f32x4){0.f, 0.f, 0.f, 0.f};
        }
        cur = nxt; cA = nA; cB = nB; if constexpr (SEG + 1 == Sched::NSEG) ++ti;
        if constexpr (ALIGN_EPI) { if (wr == 1) PG8_BAR; }
        return true;
    };
    for (;;) {
        if (!unit(std::integral_constant<int, 0>{})) break;
        if constexpr (Sched::NSEG > 1) { if (!unit(std::integral_constant<int, 1>{})) break; }
        if constexpr (Sched::NSEG > 2) { if (!unit(std::integral_constant<int, 2>{})) break; if (!unit(std::integral_constant<int, 3>{})) break; }
    }
    PG8_WAIT_V(0);
    if constexpr (!ALIGN_EPI) { if (wr == 0) PG8_BAR; }
    PG8_BAR;
#undef PG8_SA
#undef PG8_SB
#undef PG8_STAGE
#undef PG8_LDA
#undef PG8_LDB
#undef PG8_MMA
#undef PG8_WAIT_V
#undef PG8_WAIT_L
#undef PG8_BAR
#undef PG8_SCHED
}
}

constexpr int NWAVES = 8;
constexpr int BATCH = 8, SEQ = 2048, DM = 2048, M = BATCH * SEQ;
constexpr int HGW = 1024, ATW = 1024, KVW = 256, INW = 4 * HGW + ATW + 2 * KVW + 2 * DM;
constexpr int DFF = 4 * DM;
constexpr float EPS = 1e-6f;
constexpr int N_PHASES = 10;

constexpr size_t MiB = 1u << 20;
constexpr size_t WS_CTL = 0, CTL_ZERO_BYTES = 128 * 1024;
constexpr size_t WS_ADA = 1 * MiB;
constexpr size_t WS_LB = WS_ADA + 512 * 1024;
constexpr size_t WS_BT = WS_LB + 4096;
constexpr size_t WS_WIN = 2 * MiB, WS_WBH = 40 * MiB, WS_WBA = 44 * MiB, WS_WOUT = 48 * MiB, WS_WFF1 = 56 * MiB, WS_WFF2 = 88 * MiB;
constexpr size_t WS_ARENA = 120 * MiB;
constexpr size_t AO_QH = 0, AO_VH = 4 * MiB, AO_LOGF = 8 * MiB, AO_GH = 16 * MiB, AO_AQ = 20 * MiB, AO_AK = 24 * MiB, AO_VT = 25 * MiB, AO_XN = 26 * MiB, AO_GSCR = 34 * MiB, AO_SLOC = 42 * MiB, AO_BSEG = 44 * MiB;
constexpr size_t AO_MERGED = 0;
constexpr size_t AO_H = 0, AO_XN2 = 32 * MiB, AO_D1 = 40 * MiB;
constexpr size_t WS_END = 504 * MiB;
constexpr int CW_BAR = 4096;
constexpr int CW_XCC = 15360;

constexpr int RING_OFF = 0, RING_BYTES = 131072;
constexpr int P0_SCR = 16640;
constexpr int LDSCTL_OFF = 8 * P0_SCR, MISC_OFF = LDSCTL_OFF + 320;
static_assert(LDSCTL_OFF >= RING_BYTES, "lds map");
constexpr int LDS_BYTES = 147456;

#define GAS __attribute__((address_space(1)))
#define LAS __attribute__((address_space(3)))
typedef unsigned short bf16;
typedef unsigned v4u __attribute__((ext_vector_type(4)));
typedef unsigned v2u __attribute__((ext_vector_type(2)));
typedef float f32x4 __attribute__((ext_vector_type(4)));
typedef float f32x16 __attribute__((ext_vector_type(16)));
typedef short bf16x8 __attribute__((ext_vector_type(8)));
typedef short s16x4 __attribute__((ext_vector_type(4)));
#define LDS_WAIT() asm volatile("s_waitcnt lgkmcnt(0)" ::: "memory")
using pg8::cvtpk; using pg8::bflo; using pg8::bfhi; using pg8::fast_exp;
__device__ __forceinline__ unsigned f2bf(float f) { return pg8::cvtpk(f, 0.f) & 0xffffu; }
__device__ __forceinline__ float bf2f(unsigned short h) { return __uint_as_float((unsigned)h << 16); }

#define XB_TMO      128
#define XB_XCNT(j)  (256  + 64 * (j))
#define XB_XSUB(j)  (1280 + 64 * (j))
#define XB_XGEN(j)  (2304 + 64 * (j))
#define XB_TOP      3328
#define XB_TOPGEN   3392
#define XCD_BAR_WORDS 3456
#define XB_SPIN_CAP (1u << 18)
__device__ __forceinline__ unsigned xb_ld(unsigned* p)              { return __hip_atomic_load(p, __ATOMIC_RELAXED, __HIP_MEMORY_SCOPE_AGENT); }
__device__ __forceinline__ unsigned xb_add(unsigned* p, unsigned v) { return __hip_atomic_fetch_add(p, v, __ATOMIC_RELAXED, __HIP_MEMORY_SCOPE_AGENT); }
__device__ __forceinline__ unsigned xb_xcc_id() { return (unsigned)__builtin_amdgcn_s_getreg((3 << 11) | 20) & 0xFu; }
#define XB_SPIN(cond, bar) do { unsigned _sp = 0; while (cond) { __builtin_amdgcn_s_sleep(1); \
    if ((++_sp & 255u) == 0u) { if (xb_ld(&(bar)[XB_TMO])) break; if (_sp > XB_SPIN_CAP) { atomicAdd(&(bar)[XB_TMO], 1u); break; } } } } while (0)
struct XcdBarrier { unsigned* bar; unsigned x; volatile LAS unsigned* st; };
__device__ __forceinline__ XcdBarrier xcd_barrier_post(unsigned* bar, volatile LAS unsigned* st) {
    XcdBarrier b; b.bar = bar; b.x = xb_xcc_id(); b.st = st;
    if (threadIdx.x == 0) (void)xb_add(&bar[XB_XCNT(b.x)], 1u);
    return b;
}
__device__ __forceinline__ void xcd_barrier_complete(unsigned* bar, unsigned x, unsigned& nloc, unsigned& nx) {
    const unsigned G = gridDim.x * gridDim.y * gridDim.z;
    unsigned sum, cnt, mine, sp = 0u;
    for (;;) {
        sum = 0u; cnt = 0u; mine = 0u;
#pragma unroll
        for (unsigned j = 0; j < 16; ++j) { const unsigned c = xb_ld(&bar[XB_XCNT(j)]); sum += c; cnt += (c > 0u) ? 1u : 0u; mine = (j == x) ? c : mine; }
        if (sum == G) break;
        __builtin_amdgcn_s_sleep(1);
        if ((++sp & 255u) == 0u) { if (xb_ld(&bar[XB_TMO])) break; if (sp > XB_SPIN_CAP) { atomicAdd(&bar[XB_TMO], 1u); break; } }
    }
    nloc = mine > 0u ? mine : 1u; nx = cnt > 0u ? cnt : 1u;
}
__device__ __forceinline__ void xcd_barrier(const XcdBarrier& b) {
    asm volatile("s_waitcnt vmcnt(0)" ::: "memory");
    __syncthreads();
    if (threadIdx.x == 0) {
        unsigned* bar = b.bar;
        __builtin_amdgcn_s_waitcnt(0);
        unsigned nloc = b.st[0], nx = b.st[1];
        if (nloc == 0u) { xcd_barrier_complete(bar, b.x, nloc, nx); b.st[0] = nloc; b.st[1] = nx; }
        const unsigned old = xb_add(&bar[XB_XSUB(b.x)], 1u);
        const unsigned gen = old / nloc;
        if (old + 1u == (gen + 1u) * nloc) {
            __builtin_amdgcn_fence(__ATOMIC_RELEASE, "agent");
            asm volatile("s_waitcnt vmcnt(0)" ::: "memory");
            const unsigned og = xb_add(&bar[XB_TOP], 1u);
            const unsigned tg = og / nx;
            if (og + 1u == (tg + 1u) * nx) xb_add(&bar[XB_TOPGEN], 1u);
            else XB_SPIN(xb_ld(&bar[XB_TOPGEN]) == tg, bar);
            __builtin_amdgcn_fence(__ATOMIC_ACQUIRE, "agent");
            xb_add(&bar[XB_XGEN(b.x)], 1u);
            asm volatile("s_waitcnt vmcnt(0)" ::: "memory");
        } else {
            XB_SPIN(xb_ld(&bar[XB_XGEN(b.x)]) == gen, bar);
            __builtin_amdgcn_fence(__ATOMIC_ACQUIRE, "agent");
            asm volatile("s_waitcnt vmcnt(0)" ::: "memory");
        }
    }
    __syncthreads();
}

__device__ __forceinline__ void xcd_barrier_local(const XcdBarrier& b) {
    asm volatile("s_waitcnt vmcnt(0)" ::: "memory");
    __syncthreads();
    if (threadIdx.x == 0) {
        unsigned* bar = b.bar;
        __builtin_amdgcn_s_waitcnt(0);
        unsigned nloc = b.st[0], nx = b.st[1];
        if (nloc == 0u) { xcd_barrier_complete(bar, b.x, nloc, nx); b.st[0] = nloc; b.st[1] = nx; }
        const unsigned old = xb_add(&bar[XB_XSUB(b.x)], 1u);
        const unsigned gen = old / nloc;
        if (old + 1u == (gen + 1u) * nloc) xb_add(&bar[XB_XGEN(b.x)], 1u);
        else XB_SPIN(xb_ld(&bar[XB_XGEN(b.x)]) == gen, bar);
        __builtin_amdgcn_fence(__ATOMIC_ACQUIRE, "agent");
        asm volatile("s_waitcnt vmcnt(0)" ::: "memory");
    }
    __syncthreads();
}

__device__ __forceinline__ unsigned xcd_barrier_local_arrive(const XcdBarrier& b) {
    asm volatile("s_waitcnt vmcnt(0)" ::: "memory");
    __syncthreads();
    unsigned tok = ~0u;
    if (threadIdx.x == 0) {
        unsigned* bar = b.bar;
        __builtin_amdgcn_s_waitcnt(0);
        unsigned nloc = b.st[0], nx = b.st[1];
        if (nloc == 0u) { xcd_barrier_complete(bar, b.x, nloc, nx); b.st[0] = nloc; b.st[1] = nx; }
        const unsigned old = xb_add(&bar[XB_XSUB(b.x)], 1u);
        const unsigned gen = old / nloc;
        if (old + 1u == (gen + 1u) * nloc) xb_add(&bar[XB_XGEN(b.x)], 1u); else tok = gen;
    }
    return tok;
}
__device__ __forceinline__ void xcd_barrier_local_wait(const XcdBarrier& b, unsigned tok) {
    if (threadIdx.x == 0) {
        unsigned* bar = b.bar;
        if (tok != ~0u) XB_SPIN(xb_ld(&bar[XB_XGEN(b.x)]) == tok, bar);
        __builtin_amdgcn_fence(__ATOMIC_ACQUIRE, "agent");
        asm volatile("s_waitcnt vmcnt(0)" ::: "memory");
    }
    __syncthreads();
}

__device__ __forceinline__ float wave_sum(float v) {
#pragma unroll
    for (int o = 1; o < 64; o <<= 1) v += __shfl_xor(v, o);
    return v;
}

struct Args { const float* in[18]; float* out; unsigned char* ws; int ph_lo, ph_hi, li, pad; };

struct TileD { const float* src; unsigned char* dst; int N, nh; };
__device__ __forceinline__ void tile_load(const TileD& d, f32x4 (&v)[16], int lane) {
    const int lr = lane >> 4, lc = 4 * (lane & 15);
#pragma unroll
    for (int i = 0; i < 16; ++i) v[i] = __builtin_nontemporal_load((const GAS f32x4*)(d.src + (size_t)(4 * i + lr) * d.N + lc));
}
__device__ __forceinline__ void tile_store(const TileD& d, const f32x4 (&v)[16], LAS float* scr, int lane) {
    const int lr = lane >> 4, lc = 4 * (lane & 15);
#pragma unroll
    for (int i = 0; i < 16; ++i) { LAS float* p = scr + (4 * i + lr) * 65 + lc; p[0] = v[i][0]; p[1] = v[i][1]; p[2] = v[i][2]; p[3] = v[i][3]; }
    LDS_WAIT(); asm volatile("" ::: "memory");
    const int c = lane & 7;
#pragma unroll
    for (int j = 0; j < 8; ++j) { const int n = (lane >> 3) + 8 * j; const LAS float* sp = scr + (8 * c) * 65 + n;
        v4u o; o.x = cvtpk(sp[0 * 65], sp[1 * 65]); o.y = cvtpk(sp[2 * 65], sp[3 * 65]); o.z = cvtpk(sp[4 * 65], sp[5 * 65]); o.w = cvtpk(sp[6 * 65], sp[7 * 65]);
        const int nn = d.nh + n, x = nn & 31, slot = (nn & ~31) + 16 * ((x >> 2) & 1) + 4 * (x >> 3) + (x & 3);
        *(GAS v4u*)(d.dst + pg8::lds_byte(slot, 8 * c)) = o; }
    LDS_WAIT(); asm volatile("" ::: "memory");
}
template <class D> __device__ __forceinline__ void transpose_items(const D& desc, int first, int stride, int end, LAS float* scr, int lane) {
    if (first >= end) return;
    const int last = first + ((end - 1 - first) / stride) * stride;
    f32x4 va[16], vb[16];
    int it = first; TileD a = desc(it), b; tile_load(a, va, lane);
    for (;;) {
        const int i2 = it + stride; b = desc(i2 < end ? i2 : last); tile_load(b, vb, lane);
        tile_store(a, va, scr, lane);
        if (i2 >= end) break;
        it = i2 + stride; a = desc(it < end ? it : last); tile_load(a, va, lane);
        tile_store(b, vb, scr, lane);
        if (it >= end) break;
    }
}
struct DescWin { const float* w; bf16* wt;
    __device__ __forceinline__ TileD operator()(int it) const { const int kb = it / (INW / 64), nb = it % (INW / 64); return TileD{w + (size_t)(64 * kb) * INW + 64 * nb, (unsigned char*)wt + ((size_t)(nb >> 1) * (DM / 64) + kb) * 16384, INW, (nb & 1) * 64}; } };
struct DescRest { const float *w_bh, *w_ba, *w_out, *w_ff1, *w_ff2; bf16 *WBH, *WBA, *WOUT, *WFF1, *WFF2;
    static constexpr int I_BH = (HGW / 64) * (DM / 64), I_OUT = (DM / 64) * (DM / 64), I_F1 = (DM / 64) * (DFF / 64), I_F2 = (DFF / 64) * (DM / 64), NITEMS = 2 * I_BH + I_OUT + I_F1 + I_F2;
    __device__ __forceinline__ TileD operator()(int it) const {
        const float* w; bf16* wt; int K, N, r = it;
        if (r < I_BH) { w = w_bh; wt = WBH; K = HGW; N = DM; }
        else if ((r -= I_BH) < I_BH) { w = w_ba; wt = WBA; K = ATW; N = DM; }
        else if ((r -= I_BH) < I_OUT) { w = w_out; wt = WOUT; K = DM; N = DM; }
        else if ((r -= I_OUT) < I_F1) { w = w_ff1; wt = WFF1; K = DM; N = DFF; }
        else { r -= I_F1; w = w_ff2; wt = WFF2; K = DFF; N = DM; }
        const int nblk = N / 64, kb = r / nblk, nb = r % nblk;
        return TileD{w + (size_t)(64 * kb) * N + 64 * nb, (unsigned char*)wt + ((size_t)(nb >> 1) * (K / 64) + kb) * 16384, N, (nb & 1) * 64}; } };

__device__ __forceinline__ void p0_ada(LAS unsigned char* lds, const float* c, const float* w_ada, const float* b_ada, float* ada, int blk, int tid) {
    LAS float* cact = (LAS float*)lds;
    LAS float* red = (LAS float*)(lds + 65536);
    for (int i = tid; i < 8 * 2048; i += 512) { const int b = i >> 11, k = i & 2047; const float x = c[i]; cact[k * 8 + b] = x * pg8::sigmoidf_(x); }
    __syncthreads();
    const int cq = tid & 15, kg = tid >> 4;
    f32x4 acc[8];
#pragma unroll
    for (int b = 0; b < 8; ++b) acc[b] = (f32x4){0.f, 0.f, 0.f, 0.f};
    const float* wp = w_ada + (size_t)kg * 12288 + 64 * blk + 4 * cq;
#pragma unroll 8
    for (int i = 0; i < 64; ++i) {
        const f32x4 w = __builtin_nontemporal_load((const f32x4*)(wp + (size_t)i * 32 * 12288));
        const int k = kg + 32 * i;
        const f32x4 c0 = *(const LAS f32x4*)(cact + k * 8), c1 = *(const LAS f32x4*)(cact + k * 8 + 4);
        acc[0] += w * c0[0]; acc[1] += w * c0[1]; acc[2] += w * c0[2]; acc[3] += w * c0[3];
        acc[4] += w * c1[0]; acc[5] += w * c1[1]; acc[6] += w * c1[2]; acc[7] += w * c1[3];
    }
#pragma unroll
    for (int b = 0; b < 8; ++b) *(LAS f32x4*)(red + (kg * 8 + b) * 64 + 4 * cq) = acc[b];
    __syncthreads();
    { const int b = tid >> 6, col = tid & 63; float s = 0.f;
#pragma unroll 8
      for (int g = 0; g < 32; ++g) s += red[(g * 8 + b) * 64 + col];
      ada[b * 12288 + 64 * blk + col] = s + b_ada[64 * blk + col]; }
    __syncthreads();
}

template <bool DELTA>
__device__ __forceinline__ void norm_rows(const float* src, const bf16* delta, const float* g, const float* shift, const float* scale, bf16* dst, int bx, int wave, int lane) {
    const int b = bx & 7, r0 = (bx >> 3) * NWAVES + wave;
    const float* shb = shift + b * 12288; const float* scb = scale + b * 12288;
    constexpr bool HOIST = !DELTA;
    f32x4 gm[8], shv[8];
    if constexpr (HOIST) {
#pragma unroll
    for (int j = 0; j < 8; ++j) { const int col = 4 * lane + 256 * j; gm[j] = *(const f32x4*)(g + col) * (*(const f32x4*)(scb + col) + 1.0f); shv[j] = *(const f32x4*)(shb + col); } }
    for (int k = 0; k < 8; k += 2) {
        const int m0 = b * SEQ + r0 + 256 * k, m1 = m0 + 256;
        const GAS f32x4* x0 = (const GAS f32x4*)(src + (size_t)m0 * DM) + lane; const GAS f32x4* x1 = (const GAS f32x4*)(src + (size_t)m1 * DM) + lane;
        f32x4 v0[8], v1[8];
#pragma unroll
        for (int j = 0; j < 8; ++j) { v0[j] = __builtin_nontemporal_load(&x0[64 * j]); v1[j] = __builtin_nontemporal_load(&x1[64 * j]); }
        if (DELTA) {
            const GAS v2u* d0 = (const GAS v2u*)(delta + (size_t)m0 * DM) + lane; const GAS v2u* d1 = (const GAS v2u*)(delta + (size_t)m1 * DM) + lane;
            v2u e0[8], e1[8];
#pragma unroll
            for (int j = 0; j < 8; ++j) { e0[j] = d0[64 * j]; e1[j] = d1[64 * j]; }
#pragma unroll
            for (int j = 0; j < 8; ++j) { v0[j].x += bflo(e0[j].x); v0[j].y += bfhi(e0[j].x); v0[j].z += bflo(e0[j].y); v0[j].w += bfhi(e0[j].y);
                                          v1[j].x += bflo(e1[j].x); v1[j].y += bfhi(e1[j].x); v1[j].z += bflo(e1[j].y); v1[j].w += bfhi(e1[j].y); }
        }
        float s0 = 0.f, s1 = 0.f;
#pragma unroll
        for (int j = 0; j < 8; ++j) { s0 += (v0[j].x * v0[j].x + v0[j].y * v0[j].y) + (v0[j].z * v0[j].z + v0[j].w * v0[j].w); s1 += (v1[j].x * v1[j].x + v1[j].y * v1[j].y) + (v1[j].z * v1[j].z + v1[j].w * v1[j].w); }
        const float ra = rsqrtf(wave_sum(s0) * (1.f / DM) + EPS), rb = rsqrtf(wave_sum(s1) * (1.f / DM) + EPS);
        GAS unsigned char* o0 = (GAS unsigned char*)dst + ((size_t)(m0 >> 7) * (DM / 64)) * 16384; GAS unsigned char* o1 = (GAS unsigned char*)dst + ((size_t)(m1 >> 7) * (DM / 64)) * 16384;
#pragma unroll
        for (int j = 0; j < 8; ++j) { const int col = 4 * lane + 256 * j;
            f32x4 gmj, shj;
            if constexpr (HOIST) { gmj = gm[j]; shj = shv[j]; } else { gmj = *(const f32x4*)(g + col) * (*(const f32x4*)(scb + col) + 1.0f); shj = *(const f32x4*)(shb + col); }
            const f32x4 ya = (v0[j] * ra) * gmj + shj, yb = (v1[j] * rb) * gmj + shj;
            v2u wa, wb; wa.x = cvtpk(ya.x, ya.y); wa.y = cvtpk(ya.z, ya.w); wb.x = cvtpk(yb.x, yb.y); wb.y = cvtpk(yb.z, yb.w);
            *(GAS v2u*)(o0 + (size_t)(col >> 6) * 16384 + pg8::lds_byte(m0 & 127, col & 63)) = wa; *(GAS v2u*)(o1 + (size_t)(col >> 6) * 16384 + pg8::lds_byte(m1 & 127, col & 63)) = wb; }
    }
}

namespace hg {
constexpr int QS = 144, TS = 80;
constexpr int OFF_QT = 0, OFF_KT = 64 * QS * 2, OFF_KTT = 2 * OFF_KT, OFF_VT = OFF_KTT + 128 * TS * 2, OFF_P = OFF_VT + 128 * TS * 2, OFF_ST = OFF_P + 64 * TS * 2, OFF_SEG = OFF_ST + 128 * QS * 2, OFF_FAC = OFF_SEG + 4096, LDS_END = OFF_FAC + 1536;
static_assert(LDS_END <= RING_BYTES, "hgrn lds");
__device__ __forceinline__ bf16x8 ldfrag(const LAS unsigned char* base, int row, int stride, int k) { return *(const LAS bf16x8*)(base + (row * stride + k) * 2); }
#define MFMA16(a, b, c) __builtin_amdgcn_mfma_f32_16x16x32_bf16((a), (b), (c), 0, 0, 0)
typedef float f32x2 __attribute__((ext_vector_type(2)));

__device__ __forceinline__ void hgrn_seg(LAS unsigned char* lds, int bh, int j, const bf16* QH, const float* LOGF, const bf16* VH, bf16* OLOC, bf16* QC, float* SLOC, float* BSEG) {
    const int tid = threadIdx.x, lane = tid & 63, w = __builtin_amdgcn_readfirstlane(tid >> 6);
    const int b = bh >> 3, h = bh & 7;
    const int d0 = 2 * lane;
    const int l15 = lane & 15, lq = lane >> 4;
    LAS float* SEG = (LAS float*)(lds + OFF_SEG); LAS float* FAC = (LAS float*)(lds + OFF_FAC);
    const size_t colh = (size_t)h * 128;
    const size_t rowb = (size_t)b * SEQ + (size_t)j * 512;
    f32x2 lf[8]; unsigned qv[8], vv[8];
    { const size_t base = (rowb + 8 * w) * 1024 + colh + d0;
#pragma unroll
      for (int i = 0; i < 8; ++i) { lf[i] = *(const f32x2*)(LOGF + base + (size_t)i * 1024); qv[i] = *(const unsigned*)(QH + base + (size_t)i * 1024); vv[i] = *(const unsigned*)(VH + base + (size_t)i * 1024); } }
    f32x4 S[8];
#pragma unroll
    for (int i = 0; i < 8; ++i) S[i] = (f32x4){0.f, 0.f, 0.f, 0.f};
    const int tt = w & 3, vh = w >> 2;
    f32x2 coff = (f32x2){0.f, 0.f};

    for (int n = 0; n < 8; ++n) {
        { f32x2 run = (f32x2){0.f, 0.f};
#pragma unroll
          for (int i = 0; i < 8; ++i) run += lf[i];
          *(LAS f32x2*)(SEG + w * 128 + d0) = run; }
        __syncthreads();
        {
            f32x2 off = (f32x2){0.f, 0.f}, ref = (f32x2){0.f, 0.f}, blast = (f32x2){0.f, 0.f};
#pragma unroll
            for (int k = 0; k < 8; ++k) { const f32x2 sk = *(const LAS f32x2*)(SEG + k * 128 + d0); if (k < w) off += sk; if (k < 4) ref += sk; blast += sk; }
            if (w == 0) {
                *(LAS f32x2*)(FAC + d0) = (f32x2){fast_exp(ref.x), fast_exp(ref.y)};
                *(LAS f32x2*)(FAC + 128 + d0) = (f32x2){fast_exp(blast.x), fast_exp(blast.y)};
                *(LAS f32x2*)(FAC + 256 + d0) = (f32x2){fast_exp(blast.x - ref.x), fast_exp(blast.y - ref.y)}; }
            const float X0 = fast_exp(ref.x + coff.x), X1 = fast_exp(ref.y + coff.y);
            coff += blast;
            unsigned kA[4], kB[4], vA[4], vB[4];
            float E0 = fast_exp(off.x - ref.x), E1 = fast_exp(off.y - ref.y);
            bf16* qcp = QC + (rowb + 64 * n + 8 * w) * 1024 + colh + d0;
#pragma unroll
            for (int i = 0; i < 8; i += 2) {
                float kt[2][2];
#pragma unroll
                for (int e = 0; e < 2; ++e) {
                    const float f0 = fast_exp(lf[i + e].x), f1 = fast_exp(lf[i + e].y);
                    E0 *= f0; E1 *= f1;
                    const float q0 = bflo(qv[i + e]) * E0, q1 = bfhi(qv[i + e]) * E1;
                    kt[e][0] = (1.0f - f0) * __builtin_amdgcn_rcpf(E0); kt[e][1] = (1.0f - f1) * __builtin_amdgcn_rcpf(E1);
                    const int t = 8 * w + i + e;
                    *(LAS unsigned*)(lds + OFF_QT + (t * QS + d0) * 2) = cvtpk(q0, q1);
                    *(LAS unsigned*)(lds + OFF_KT + (t * QS + d0) * 2) = cvtpk(kt[e][0], kt[e][1]);
                    *(unsigned*)(qcp + (size_t)(i + e) * 1024) = cvtpk(q0 * X0, q1 * X1);
                }
                kA[i >> 1] = cvtpk(kt[0][0], kt[1][0]); kB[i >> 1] = cvtpk(kt[0][1], kt[1][1]);
                vA[i >> 1] = (vv[i] & 0xffffu) | (vv[i + 1] << 16); vB[i >> 1] = (vv[i] >> 16) | (vv[i + 1] & 0xffff0000u);
            }
            *(LAS v4u*)(lds + OFF_KTT + (d0 * TS + 8 * w) * 2) = (v4u){kA[0], kA[1], kA[2], kA[3]};
            *(LAS v4u*)(lds + OFF_KTT + ((d0 + 1) * TS + 8 * w) * 2) = (v4u){kB[0], kB[1], kB[2], kB[3]};
            *(LAS v4u*)(lds + OFF_VT + (d0 * TS + 8 * w) * 2) = (v4u){vA[0], vA[1], vA[2], vA[3]};
            *(LAS v4u*)(lds + OFF_VT + ((d0 + 1) * TS + 8 * w) * 2) = (v4u){vB[0], vB[1], vB[2], vB[3]};
        }
        { const int nn = (n + 1 < 8) ? n + 1 : n;
          const size_t base = (rowb + 64 * nn + 8 * w) * 1024 + colh + d0;
#pragma unroll
            for (int i = 0; i < 8; ++i) { lf[i] = *(const f32x2*)(LOGF + base + (size_t)i * 1024); qv[i] = *(const unsigned*)(QH + base + (size_t)i * 1024); vv[i] = *(const unsigned*)(VH + base + (size_t)i * 1024); } }
        __syncthreads();
        {
            const int ti = w >> 1;
#pragma unroll
            for (int jj = 0; jj < 2; ++jj) { const int si = 2 * (w & 1) + jj; f32x4 a = (f32x4){0.f, 0.f, 0.f, 0.f};
                if (si <= ti) {
#pragma unroll
                    for (int ks = 0; ks < 4; ++ks) a = MFMA16(ldfrag(lds + OFF_KT, 16 * si + l15, QS, 32 * ks + 8 * lq), ldfrag(lds + OFF_QT, 16 * ti + l15, QS, 32 * ks + 8 * lq), a); }
                const int t = 16 * ti + l15, s0 = 16 * si + 4 * lq;
                v2u pw; pw.x = cvtpk(s0 <= t ? a[0] : 0.f, s0 + 1 <= t ? a[1] : 0.f); pw.y = cvtpk(s0 + 2 <= t ? a[2] : 0.f, s0 + 3 <= t ? a[3] : 0.f);
                *(LAS v2u*)(lds + OFF_P + (t * TS + s0) * 2) = pw; }
#pragma unroll
            for (int dt = 0; dt < 8; ++dt) { const f32x4 e = *(const LAS f32x4*)(FAC + 16 * dt + 4 * lq);
                S[dt] = S[dt] * e;
                v2u sw; sw.x = cvtpk(S[dt][0], S[dt][1]); sw.y = cvtpk(S[dt][2], S[dt][3]);
                *(LAS v2u*)(lds + OFF_ST + ((16 * w + l15) * QS + 16 * dt + 4 * lq) * 2) = sw; }
        }
        __syncthreads();
        {
            f32x4 o[4];
#pragma unroll
            for (int vt = 0; vt < 4; ++vt) o[vt] = (f32x4){0.f, 0.f, 0.f, 0.f};
#pragma unroll
            for (int ks = 0; ks < 2; ++ks) { const bf16x8 pb = ldfrag(lds + OFF_P, 16 * tt + l15, TS, 32 * ks + 8 * lq);
#pragma unroll
                for (int vt = 0; vt < 4; ++vt) o[vt] = MFMA16(ldfrag(lds + OFF_VT, 16 * (4 * vh + vt) + l15, TS, 32 * ks + 8 * lq), pb, o[vt]); }
#pragma unroll
            for (int ks = 0; ks < 4; ++ks) { const bf16x8 qb = ldfrag(lds + OFF_QT, 16 * tt + l15, QS, 32 * ks + 8 * lq);
#pragma unroll
                for (int vt = 0; vt < 4; ++vt) o[vt] = MFMA16(ldfrag(lds + OFF_ST, 16 * (4 * vh + vt) + l15, QS, 32 * ks + 8 * lq), qb, o[vt]); }
#pragma unroll
            for (int ks = 0; ks < 2; ++ks) { const bf16x8 vb = ldfrag(lds + OFF_VT, 16 * w + l15, TS, 32 * ks + 8 * lq);
#pragma unroll
                for (int dt = 0; dt < 8; ++dt) S[dt] = MFMA16(ldfrag(lds + OFF_KTT, 16 * dt + l15, TS, 32 * ks + 8 * lq), vb, S[dt]); }
#pragma unroll
            for (int dt = 0; dt < 8; ++dt) S[dt] = S[dt] * *(const LAS f32x4*)(FAC + 256 + 16 * dt + 4 * lq);
            bf16* op = OLOC + (rowb + 64 * n + 16 * tt + l15) * 1024 + colh + 64 * vh + 4 * lq;
#pragma unroll
            for (int vt = 0; vt < 4; ++vt) { v2u wv; wv.x = cvtpk(o[vt][0], o[vt][1]); wv.y = cvtpk(o[vt][2], o[vt][3]); *(v2u*)(op + 16 * vt) = wv; }
        }
    }
    { float* sp = SLOC + ((size_t)(bh * 4 + j) * 128 + 16 * w + l15) * 128 + 4 * lq;
#pragma unroll
      for (int dt = 0; dt < 8; ++dt) *(f32x4*)(sp + 16 * dt) = S[dt];
      if (w == 0) *(f32x2*)(BSEG + (size_t)(bh * 4 + j) * 128 + d0) = coff; }
    __syncthreads();
}

constexpr int OFF_SI = 0;
__device__ __forceinline__ void hgrn_fix(LAS unsigned char* lds, int bh, int j, const bf16* OLOC, const bf16* QC, const float* SLOC, const float* BSEG, const bf16* GH, const float* gout, bf16* OHG) {
    const int tid = threadIdx.x, lane = tid & 63, w = __builtin_amdgcn_readfirstlane(tid >> 6);
    const int b = bh >> 3, h = bh & 7;
    const int l15 = lane & 15, lq = lane >> 4;
    const size_t colh = (size_t)h * 128;
    const size_t rowb = (size_t)b * SEQ + (size_t)j * 512;
    if (j > 0) {
        const int v = tid >> 2, dq = 32 * (tid & 3);
        f32x4 a[8];
        { const float* sp = SLOC + ((size_t)(bh * 4) * 128 + v) * 128 + dq;
#pragma unroll
          for (int i = 0; i < 8; ++i) a[i] = *(const f32x4*)(sp + 4 * i); }
        for (int sg = 1; sg < j; ++sg) {
            const float* sp = SLOC + ((size_t)(bh * 4 + sg) * 128 + v) * 128 + dq; const float* bp = BSEG + (size_t)(bh * 4 + sg) * 128 + dq;
#pragma unroll
            for (int i = 0; i < 8; ++i) { const f32x4 bs = *(const f32x4*)(bp + 4 * i), sl = *(const f32x4*)(sp + 4 * i);
                a[i][0] = a[i][0] * fast_exp(bs[0]) + sl[0]; a[i][1] = a[i][1] * fast_exp(bs[1]) + sl[1]; a[i][2] = a[i][2] * fast_exp(bs[2]) + sl[2]; a[i][3] = a[i][3] * fast_exp(bs[3]) + sl[3]; }
        }
#pragma unroll
        for (int i = 0; i < 8; i += 2) { v4u wv; wv.x = cvtpk(a[i][0], a[i][1]); wv.y = cvtpk(a[i][2], a[i][3]); wv.z = cvtpk(a[i + 1][0], a[i + 1][1]); wv.w = cvtpk(a[i + 1][2], a[i + 1][3]);
            *(LAS v4u*)(lds + OFF_SI + (v * QS + dq + 4 * i) * 2) = wv; }
    }
    __syncthreads();
    f32x4 gg[8];
#pragma unroll
    for (int vt = 0; vt < 8; ++vt) gg[vt] = *(const f32x4*)(gout + 16 * vt + 4 * lq);
#define FIX_LOAD(I4, OL, GT, QB) do { const size_t rb_ = (rowb + 64 * w + 16 * (I4) + l15) * 1024 + colh; \
        _Pragma("unroll") for (int vt = 0; vt < 8; ++vt) { OL[vt] = *(const v2u*)(OLOC + rb_ + 16 * vt + 4 * lq); GT[vt] = *(const v2u*)(GH + rb_ + 16 * vt + 4 * lq); } \
        if (j > 0) { _Pragma("unroll") for (int ks = 0; ks < 4; ++ks) QB[ks] = *(const bf16x8*)(QC + rb_ + 32 * ks + 8 * lq); } } while (0)
#define FIX_PROC(I4, OL, GT, QB) do { const int t = 64 * w + 16 * (I4) + l15; \
        f32x4 o[8]; \
        _Pragma("unroll") for (int vt = 0; vt < 8; ++vt) o[vt] = (f32x4){0.f, 0.f, 0.f, 0.f}; \
        if (j > 0) { _Pragma("unroll") for (int ks = 0; ks < 4; ++ks) { _Pragma("unroll") for (int vt = 0; vt < 8; ++vt) o[vt] = MFMA16(ldfrag(lds + OFF_SI, 16 * vt + l15, QS, 32 * ks + 8 * lq), QB[ks], o[vt]); } } \
        float ss = 0.f; \
        _Pragma("unroll") for (int vt = 0; vt < 8; ++vt) { o[vt][0] += bflo(OL[vt].x); o[vt][1] += bfhi(OL[vt].x); o[vt][2] += bflo(OL[vt].y); o[vt][3] += bfhi(OL[vt].y); \
            ss += (o[vt][0] * o[vt][0] + o[vt][1] * o[vt][1]) + (o[vt][2] * o[vt][2] + o[vt][3] * o[vt][3]); } \
        ss += __shfl_xor(ss, 16); ss += __shfl_xor(ss, 32); \
        const float r = rsqrtf(ss * (1.f / 128.f) + EPS); \
        _Pragma("unroll") for (int vt = 0; vt < 8; ++vt) { v2u wv; \
            wv.x = cvtpk(o[vt][0] * r * gg[vt][0] * bflo(GT[vt].x), o[vt][1] * r * gg[vt][1] * bfhi(GT[vt].x)); \
            wv.y = cvtpk(o[vt][2] * r * gg[vt][2] * bflo(GT[vt].y), o[vt][3] * r * gg[vt][3] * bfhi(GT[vt].y)); \
            *(v2u*)((char*)OHG + pg8::blk_off((int)(rowb + t), (int)colh + 16 * vt + 4 * lq, HGW / 64)) = wv; } } while (0)
    { v2u olA[8], gtA[8], olB[8], gtB[8]; bf16x8 qbA[4], qbB[4];
      FIX_LOAD(0, olA, gtA, qbA); FIX_LOAD(1, olB, gtB, qbB);
      FIX_PROC(0, olA, gtA, qbA); FIX_LOAD(2, olA, gtA, qbA);
      FIX_PROC(1, olB, gtB, qbB); FIX_LOAD(3, olB, gtB, qbB);
      FIX_PROC(2, olA, gtA, qbA);
      FIX_PROC(3, olB, gtB, qbB); }
#undef FIX_LOAD
#undef FIX_PROC
    __syncthreads();
}
}

namespace at {
#define MFMA32(a, b, c) __builtin_amdgcn_mfma_f32_32x32x16_bf16((a), (b), (c), 0, 0, 0)
__device__ __forceinline__ int crow(int r, int hi) { return (r & 3) + 8 * (r >> 2) + 4 * hi; }
constexpr float NEG = -1e30f;
constexpr float L2E = 1.4426950408889634f;
constexpr int KS = 72, VS = 264;
constexpr int OFF_K = 0, OFF_V = 256 * KS * 2  , OFF_BT = OFF_V + 64 * VS * 2  , BTS = 192, OFF_QK = OFF_BT + 16 * BTS * 4, LDS_END = OFF_QK + 256;
static_assert(LDS_END <= RING_BYTES, "attn lds");
__device__ __forceinline__ void attn_unit(LAS unsigned char* lds, int unit, const bf16* AQ, const bf16* AK, const bf16* VT, bf16* OAT, const float* qg, const float* kg, const float* sinks) {
    const int tid = threadIdx.x, lane = tid & 63, r = lane & 31, hh = lane >> 5, w = __builtin_amdgcn_readfirstlane(tid >> 6);
    const int nq = unit & 15, kvh = (unit >> 4) & 3, b = unit >> 6;
    const int kbase = 128 * (nq - 1);
    v4u qraw[4];
    { const int g0 = w >> 1, h0 = kvh * 4 + g0, qi0 = 2 * (w & 1);
      const bf16* qp = AQ + (size_t)(b * SEQ + 128 * nq + 32 * qi0 + r) * 1024 + h0 * 64 + 8 * hh;
#pragma unroll
      for (int ks = 0; ks < 4; ++ks) qraw[ks] = *(const v4u*)(qp + 16 * ks); }
    const float sink_raw = sinks[kvh * 4 + (w >> 1)];
    { const int c = tid & 7, cv = tid & 31;
      v4u kraw[4], vraw[4];
#pragma unroll
      for (int p = 0; p < 4; ++p) { const int key = 64 * p + (tid >> 3); const int kk = (kbase + key) < 0 ? 0 : (kbase + key);
          kraw[p] = *(const v4u*)(AK + (size_t)(b * SEQ + kk) * 256 + kvh * 64 + 8 * c); }
#pragma unroll
      for (int p = 0; p < 4; ++p) { const int d = 16 * p + (tid >> 5); const int tk = (kbase + 8 * cv) < 0 ? 0 : (kbase + 8 * cv);
          vraw[p] = *(const v4u*)(VT + (size_t)((b * 4 + kvh) * 64 + d) * SEQ + tk); }
      __builtin_amdgcn_sched_barrier(0);
#pragma unroll
      for (int p = 0; p < 4; ++p) { const int key = 64 * p + (tid >> 3); const v4u raw = kraw[p];
          float ss = 0.f;
#pragma unroll
          for (int e = 0; e < 4; ++e) { const float a0 = bflo(raw[e]), a1 = bfhi(raw[e]); ss += a0 * a0 + a1 * a1; }
          ss += __shfl_xor(ss, 1); ss += __shfl_xor(ss, 2); ss += __shfl_xor(ss, 4);
          const float rk = rsqrtf(ss * (1.f / 64.f) + EPS);
          v4u o;
#pragma unroll
          for (int e = 0; e < 4; ++e) o[e] = cvtpk(bflo(raw[e]) * rk, bfhi(raw[e]) * rk);
          *(LAS v4u*)(lds + OFF_K + (key * KS + 8 * c) * 2) = o; }
#pragma unroll
      for (int p = 0; p < 4; ++p) { const int d = 16 * p + (tid >> 5); *(LAS v4u*)(lds + OFF_V + (d * VS + 8 * cv) * 2) = vraw[p]; } }
    __syncthreads();
    const int g = w >> 1, h = kvh * 4 + g;
    const LAS float* qk = (const LAS float*)(lds + OFF_QK);
    const float sink = sink_raw * L2E;
    const LAS float* btl = (const LAS float*)(lds + OFF_BT) + h * BTS + r - 4 * hh;
#pragma unroll 1
    for (int qq = 0; qq < 2; ++qq) {
        const int qi = 2 * (w & 1) + qq;
        const int t0 = 128 * nq + 32 * qi;
        const int kt_lo = (nq == 0) ? 4 - qi : 0;
        bf16x8 qf[4];
        { v4u raw[4]; float ss = 0.f;
#pragma unroll
          for (int ks = 0; ks < 4; ++ks) { raw[ks] = qraw[ks];
#pragma unroll
              for (int e = 0; e < 4; ++e) { const float a0 = bflo(raw[ks][e]), a1 = bfhi(raw[ks][e]); ss += a0 * a0 + a1 * a1; } }
          ss += __shfl_xor(ss, 32);
          const float rq = rsqrtf(ss * (1.f / 64.f) + EPS);
#pragma unroll
          for (int ks = 0; ks < 4; ++ks) { v4u o; const f32x4 s0 = *(const LAS f32x4*)(qk + 16 * ks + 8 * hh), s1 = *(const LAS f32x4*)(qk + 16 * ks + 8 * hh + 4);
              o[0] = cvtpk(bflo(raw[ks][0]) * rq * s0[0], bfhi(raw[ks][0]) * rq * s0[1]); o[1] = cvtpk(bflo(raw[ks][1]) * rq * s0[2], bfhi(raw[ks][1]) * rq * s0[3]);
              o[2] = cvtpk(bflo(raw[ks][2]) * rq * s1[0], bfhi(raw[ks][2]) * rq * s1[1]); o[3] = cvtpk(bflo(raw[ks][3]) * rq * s1[2], bfhi(raw[ks][3]) * rq * s1[3]);
              qf[ks] = __builtin_bit_cast(bf16x8, o); } }
        f32x16 Sv[5];
#pragma unroll
        for (int kt = 0; kt < 5; ++kt) {
            if (kt >= kt_lo) {
                const LAS unsigned char* kp = lds + OFF_K + ((32 * (qi + kt) + r) * KS + 8 * hh) * 2;
                f32x16 a;
#pragma unroll
                for (int i = 0; i < 16; ++i) { const int cst = 128 - 32 * kt - (i & 3) - 8 * (i >> 2); a[i] = btl[32 + cst]; }
#pragma unroll
                for (int ks = 0; ks < 4; ++ks) a = MFMA32(*(const LAS bf16x8*)(kp + 32 * ks), qf[ks], a);
                Sv[kt] = a;
                if (kt == 2) __builtin_amdgcn_sched_barrier(0);
            } else {
#pragma unroll
                for (int i = 0; i < 16; ++i) Sv[kt][i] = NEG;
            }
        }
        float mx = sink;
#pragma unroll
        for (int kt = 0; kt < 5; ++kt)
#pragma unroll
            for (int i = 0; i < 16; ++i) mx = fmaxf(mx, Sv[kt][i]);
        mx = fmaxf(mx, __shfl_xor(mx, 32));
        float l = 0.f;
#pragma unroll
        for (int kt = 0; kt < 5; ++kt)
#pragma unroll
            for (int i = 0; i < 16; ++i) { const float p = __builtin_amdgcn_exp2f(Sv[kt][i] - mx); Sv[kt][i] = p; l += p; }
        l += __shfl_xor(l, 32);
        l += __builtin_amdgcn_exp2f(sink - mx);
        const float inv = 1.0f / l;
        { const bf16* qp = AQ + (size_t)(b * SEQ + t0 + 32 * (1 - qq) + r) * 1024 + h * 64 + 8 * hh;
#pragma unroll
          for (int ks = 0; ks < 4; ++ks) qraw[ks] = *(const v4u*)(qp + 16 * ks); }
        f32x16 O[2];
#pragma unroll
        for (int i = 0; i < 16; ++i) { O[0][i] = 0.f; O[1][i] = 0.f; }
#pragma unroll
        for (int kt = 0; kt < 5; ++kt) {
            if (kt >= kt_lo) {
#pragma unroll
                for (int s2 = 0; s2 < 2; ++s2) {
                    v4u pw;
#pragma unroll
                    for (int e = 0; e < 4; ++e) pw[e] = cvtpk(Sv[kt][8 * s2 + 2 * e], Sv[kt][8 * s2 + 2 * e + 1]);
                    const bf16x8 pb = __builtin_bit_cast(bf16x8, pw);
#pragma unroll
                    for (int dt = 0; dt < 2; ++dt) { const LAS unsigned char* vp = lds + OFF_V + ((32 * dt + r) * VS + 32 * (qi + kt) + 16 * s2 + 4 * hh) * 2;
                        const v2u lo = *(const LAS v2u*)(vp), hi = *(const LAS v2u*)(vp + 16);
                        const v4u va = (v4u){lo.x, lo.y, hi.x, hi.y};
                        O[dt] = MFMA32(__builtin_bit_cast(bf16x8, va), pb, O[dt]); }
                }
                if (kt & 1) __builtin_amdgcn_sched_barrier(0);
            }
        }
#pragma unroll
        for (int dt = 0; dt < 2; ++dt)
#pragma unroll
            for (int g4 = 0; g4 < 4; ++g4) { v2u wv; wv.x = cvtpk(O[dt][4 * g4] * inv, O[dt][4 * g4 + 1] * inv); wv.y = cvtpk(O[dt][4 * g4 + 2] * inv, O[dt][4 * g4 + 3] * inv);
                *(v2u*)((char*)OAT + pg8::blk_off(b * SEQ + t0 + r, h * 64 + 4 * hh + 32 * dt + 8 * g4, ATW / 64)) = wv; }
    }
    __syncthreads();
}
}

__global__ void __launch_bounds__(NWAVES * 64, 2) hyb_fwd(Args args) {
    extern __shared__ __attribute__((aligned(16))) unsigned char lds_raw[];
    LAS unsigned char* lds = (LAS unsigned char*)lds_raw;
    volatile LAS unsigned* MISC = (volatile LAS unsigned*)(lds + MISC_OFF);
    const int tid = threadIdx.x, lane = tid & 63, wave = __builtin_amdgcn_readfirstlane(tid >> 6);
    const int G = gridDim.x; const int bx = blockIdx.x; const int vcu = (G % 8 == 0) ? (bx % 8) * (G / 8) + bx / 8 : bx;
    unsigned char* ws = args.ws;
    unsigned* ctl = (unsigned*)(ws + WS_CTL);
    for (int u = tid; u < (LDS_BYTES - LDSCTL_OFF) / 4; u += NWAVES * 64) ((LAS unsigned*)(lds + LDSCTL_OFF))[u] = 0u;
    __syncthreads();
    XcdBarrier bar; bar.bar = ctl + CW_BAR + args.li * XCD_BAR_WORDS; bar.x = 0; bar.st = nullptr;
    if (MK_N_LAUNCHES != N_PHASES) bar = xcd_barrier_post(ctl + CW_BAR + args.li * XCD_BAR_WORDS, MISC + 8);
#ifndef LOCAL_SEAMS
#define LOCAL_SEAMS 0x1fa
#endif
    unsigned* xcctab = ctl + CW_XCC + args.li * 256;
    if (MK_N_LAUNCHES != N_PHASES && tid == 0) __hip_atomic_store(xcctab + bx, xb_xcc_id() + 1u, __ATOMIC_RELAXED, __HIP_MEMORY_SCOPE_AGENT);
    int canon = -1;
#define GRID_BAR_FULL() do { if (MK_N_LAUNCHES != N_PHASES) { xcd_barrier(bar); \
        if (canon < 0) { if (wave == 0) { \
                unsigned me_[4]; for (int q_ = 0; q_ < 4; ++q_) me_[q_] = __hip_atomic_load(xcctab + lane + 64 * q_, __ATOMIC_RELAXED, __HIP_MEMORY_SCOPE_AGENT);     \
                const unsigned rep_ = __hip_atomic_load(xcctab + (lane & 7), __ATOMIC_RELAXED, __HIP_MEMORY_SCOPE_AGENT);                                             \
                bool ok = (G == 256) & (rep_ != 0u) & (me_[0] == rep_) & (me_[1] == rep_) & (me_[2] == rep_) & (me_[3] == rep_); \
                for (int o_ = 1; o_ < 8; ++o_) ok = ok & (rep_ != (unsigned)__shfl(rep_, (lane + o_) & 7));                                                          \
                ok = __all(ok); if (lane == 0) MISC[11] = ok ? 1u : 0u; } \
            __syncthreads(); canon = (int)MISC[11]; } } } while (0)
#define GRID_BAR(k) do { if (MK_N_LAUNCHES != N_PHASES) { if (((LOCAL_SEAMS >> (k)) & 1) && canon == 1) xcd_barrier_local(bar); else GRID_BAR_FULL(); } } while (0)
    const int lo = args.ph_lo, hi = args.ph_hi;
#ifndef PH_MASK
#define PH_MASK 0xfff
#endif
#ifndef P3_MASK
#define P3_MASK 3
#endif
#define IN(k) (((PH_MASK >> (k)) & 1) && lo <= (k) && (k) < hi)
#define BOTH(k) (IN(k) && IN((k) + 1))
#ifndef REP_MASK
#define REP_MASK 0
#endif
#define REP(k) for (int rep_ = 0; rep_ < (((REP_MASK >> (k)) & 1) ? 2 : 1); ++rep_)
#define SEAM(k) do { if (BOTH(k) || rep_ == 0 && ((REP_MASK >> (k)) & 1)) GRID_BAR(k); } while (0)
    const float* x = args.in[0]; const float* c = args.in[1]; const float* w_ada = args.in[2]; const float* b_ada = args.in[3];
    const float* norm1_g = args.in[4]; const float* norm2_g = args.in[5]; const float* w_in = args.in[6]; const float* lb_logits = args.in[7];
    const float* hg_out_g = args.in[8]; const float* q_norm_g = args.in[9]; const float* k_norm_g = args.in[10]; const float* sinks = args.in[11];
    const float* rel_bias = args.in[12]; const float* w_bh = args.in[13]; const float* w_ba = args.in[14]; const float* w_out = args.in[15];
    const float* w_ff1 = args.in[16]; const float* w_ff2 = args.in[17];
    float* out = args.out;
    float* ADA = (float*)(ws + WS_ADA); float* LB = (float*)(ws + WS_LB); float* BT = (float*)(ws + WS_BT);
    bf16* WIN = (bf16*)(ws + WS_WIN); bf16* WBH = (bf16*)(ws + WS_WBH); bf16* WBA = (bf16*)(ws + WS_WBA); bf16* WOUT = (bf16*)(ws + WS_WOUT); bf16* WFF1 = (bf16*)(ws + WS_WFF1); bf16* WFF2 = (bf16*)(ws + WS_WFF2);
    unsigned char* ar = ws + WS_ARENA;
    bf16* QH = (bf16*)(ar + AO_QH); float* LOGF = (float*)(ar + AO_LOGF); bf16* VH = (bf16*)(ar + AO_VH); bf16* GH = (bf16*)(ar + AO_GH);
    bf16* AQ = (bf16*)(ar + AO_AQ); bf16* AK = (bf16*)(ar + AO_AK); bf16* VT = (bf16*)(ar + AO_VT); bf16* GSCR = (bf16*)(ar + AO_GSCR);
    bf16* MERGED = (bf16*)(ar + AO_MERGED); bf16* HB = (bf16*)(ar + AO_H); bf16* XN2 = (bf16*)(ar + AO_XN2); bf16* D1 = (bf16*)(ar + AO_D1);
    bf16* XN = (bf16*)(ar + AO_XN); bf16* OHG = (bf16*)out; bf16* OAT = (bf16*)((char*)out + 4 * MiB); bf16* QC = (bf16*)((char*)out + 8 * MiB); bf16* OLOC = (bf16*)((char*)out + 12 * MiB);
    float* SLOC = (float*)(ar + AO_SLOC); float* BSEG = (float*)(ar + AO_BSEG);
    const int gw = vcu * NWAVES + wave, NGW = G * NWAVES;

    if (IN(0)) REP(0) {
        if (bx < 192) p0_ada(lds, c, w_ada, b_ada, ADA, bx, tid);
        else if (bx == 192) {
            for (int i = tid; i < 1024; i += 512) { const float l0 = lb_logits[i], l1 = lb_logits[1024 + i]; LB[i] = 1.0f / (1.0f + expf(l1 - l0)); }
            for (int i = tid; i < 16 * 128; i += 512) { const int h = i >> 7, n = i & 127;
                int bkt = n; if (n >= 16) { bkt = 16 + (int)(logf((float)n / 16.0f) / logf(8.0f) * 16.0f); bkt = bkt > 31 ? 31 : bkt; }
                BT[i] = rel_bias[bkt * 16 + h]; }
        }
        LAS float* scr = (LAS float*)(lds + wave * P0_SCR);
        constexpr int I_IN = (DM / 64) * (INW / 64);
        const DescWin dw{w_in, WIN};
        if (bx < 192) transpose_items(dw, (bx * NWAVES + wave) * 2, 1, (bx * NWAVES + wave) * 2 + 2, scr, lane);
        else transpose_items(dw, 3072 + (bx - 192) * NWAVES + wave, 512, I_IN, scr, lane);
        SEAM(0);
    }
    if (IN(1)) REP(1) {
        norm_rows<false>(x, nullptr, norm1_g, ADA + 0 * DM, ADA + 1 * DM, lay::boff(XN, (size_t)(bx & 7) * lay::X8), bx, wave, lane);
        SEAM(1);
    }
    if (IN(2)) REP(2) {
        pg8::Gemm g{XN, XN, WIN, WIN, DM, lay::X8, lay::X8}; pg8::StaticOrder S; S.init(M, INW - 2 * DM, G, bx, P2_WGM, true);
        pg8::EpiProj E{QH, VH, GH, AQ, AK, VT, GSCR, GSCR, LOGF, LB};
        pg8::gemm_phase<pg8::EpiProj, pg8::StaticOrder, GEMM_ALIGN, GEMM_SP2>(lds + RING_OFF, g, S, E);
        if (bx >= 128) {
            LAS float* scr = (LAS float*)(lds + wave * P0_SCR);
            const DescRest dr{w_bh, w_ba, w_out, w_ff1, w_ff2, WBH, WBA, WOUT, WFF1, WFF2};
            transpose_items(dr, (bx - 128) * NWAVES + wave, 128 * NWAVES, DescRest::NITEMS, scr, lane);
        }
        SEAM(2);
    }
    const int xb = bx & 7, xi = bx >> 3;
    if (IN(3)) REP(3) {
        const size_t xbs = (size_t)xb;
        hg::hgrn_seg(lds, xb * 8 + (xi >> 2), xi & 3, lay::boff(QH, xbs * lay::X4), lay::boff(LOGF, xbs * lay::X8), lay::boff(VH, xbs * lay::X4), lay::boff(OLOC, xbs * lay::D4), lay::boff(QC, xbs * lay::D4), lay::boff(SLOC, xbs * lay::X2), lay::boff(BSEG, xbs * lay::XB));
        const bool split3 = BOTH(3) && REP_MASK == 0 && MK_N_LAUNCHES != N_PHASES && ((LOCAL_SEAMS >> 3) & 1) && canon == 1;
        unsigned tok3 = ~0u;
        if (split3) tok3 = xcd_barrier_local_arrive(bar);
        { LAS float* bt = (LAS float*)(lds + at::OFF_BT);
          static_assert(16 * at::BTS == 6 * 512, "bias table fill");
          float btv[6];
#pragma unroll
          for (int k = 0; k < 6; ++k) { const int i = tid + 512 * k, hd = i / at::BTS, e = i % at::BTS - 32; btv[k] = BT[hd * 128 + (e < 0 ? 0 : (e > 127 ? 127 : e))]; }
#pragma unroll
          for (int k = 0; k < 6; ++k) { const int i = tid + 512 * k, e = i % at::BTS - 32; bt[i] = (e >= 0 && e < 128) ? btv[k] * at::L2E : at::NEG; }
          if (tid < 64) ((LAS float*)(lds + at::OFF_QK))[tid] = q_norm_g[tid] * k_norm_g[tid] * (0.125f * at::L2E); }
        for (int e = 0; e < 2; ++e) at::attn_unit(lds, xb * 64 + xi * 2 + e, lay::boff(AQ, xbs * lay::X4), lay::boff(AK, xbs * lay::X1), lay::boff(VT, xbs * lay::X1), lay::boff(OAT, xbs * lay::D4), q_norm_g, k_norm_g, sinks);
        if (split3) xcd_barrier_local_wait(bar, tok3); else SEAM(3);
    }
    if (IN(4)) REP(4) {
        const size_t xbs = (size_t)xb;
        hg::hgrn_fix(lds, xb * 8 + (xi >> 2), xi & 3, lay::boff(OLOC, xbs * lay::D4), lay::boff(QC, xbs * lay::D4), lay::boff(SLOC, xbs * lay::X2), lay::boff(BSEG, xbs * lay::XB), lay::boff(GH, xbs * lay::X4), hg_out_g, lay::boff(OHG, xbs * lay::D4));
        SEAM(4);
    }
    if (IN(5)) REP(5) {
        pg8::Gemm4 g{XN, OHG, OAT, WIN + (size_t)22 * 256 * DM, WIN + (size_t)30 * 256 * DM, WBH, WBA, DM, HGW, lay::X8, lay::D4, lay::D4};
        pg8::QuadOrder S; S.b.init(M, DM, G, bx, P56_WGM);
        pg8::EpiMerge4 E{lay::boff(GSCR, (size_t)xb * lay::AR + (size_t)xi * 262144), MERGED};
        pg8::gemm_phase<pg8::EpiMerge4, pg8::QuadOrder, GEMM_ALIGN, GEMM_SP2, true, true, pg8::Gemm4>(lds + RING_OFF, g, S, E);
        SEAM(5);
    }
    if (IN(6)) REP(6) {
        pg8::Gemm g{MERGED, MERGED, WOUT, WOUT, DM, lay::X8, lay::X8}; pg8::StaticOrder S; S.init(M, DM, G, bx, P56_WGM);
        pg8::EpiDelta E{D1, ADA + 2 * DM, 12288};
        pg8::gemm_phase<pg8::EpiDelta, pg8::StaticOrder, GEMM_ALIGN, GEMM_SP2>(lds + RING_OFF, g, S, E);
        SEAM(6);
    }
    if (IN(7)) REP(7) {
        norm_rows<true>(x, lay::boff(D1, (size_t)(bx & 7) * lay::X8), norm2_g, ADA + 3 * DM, ADA + 4 * DM, lay::boff(XN2, (size_t)(bx & 7) * lay::X8), bx, wave, lane);
        SEAM(7);
    }
    if (IN(8)) REP(8) {
        pg8::Gemm g{XN2, XN2, WFF1, WFF1, DM, lay::X8, lay::X8}; pg8::StaticOrder S; S.init(M, DFF, G, bx, P8_WGM);
        pg8::EpiRelu2 E{HB, DFF};
        pg8::gemm_phase<pg8::EpiRelu2, pg8::StaticOrder, GEMM_ALIGN, GEMM_SP2>(lds + RING_OFF, g, S, E);
        SEAM(8);
    }
    if (IN(9)) {
        pg8::Gemm g{HB, HB, WFF2, WFF2, DFF, lay::X32, lay::X32}; pg8::StaticOrder S; S.init(M, DM, G, bx, P9_WGM);
        pg8::EpiResGate E{x, D1, out, ADA + 5 * DM, 12288};
        pg8::gemm_phase<pg8::EpiResGate, pg8::StaticOrder, GEMM_ALIGN, GEMM_SP2>(lds + RING_OFF, g, S, E);
    }
#undef IN
#undef BOTH
#undef GRID_BAR
#undef GRID_BAR_FULL
}

extern "C" void kernel_launch(void* const* d_in, const int* in_sizes, int n_in, void* d_out, int out_size, void* d_ws, size_t ws_size, hipStream_t stream) {
    static int grid = 0;
    if (grid == 0) {
        if (n_in != 18 || out_size != M * DM || ws_size < WS_END) { fprintf(stderr, "kernel_launch: unexpected shapes (n_in %d, out %d, ws %zu)\n", n_in, out_size, ws_size); grid = -1; return; }
        int dev = 0, cus = 0, per_cu = 0;
        if (hipGetDevice(&dev) != hipSuccess || hipDeviceGetAttribute(&cus, hipDeviceAttributeMultiprocessorCount, dev) != hipSuccess) { grid = -1; return; }
        if (hipFuncSetAttribute((const void*)hyb_fwd, hipFuncAttributeMaxDynamicSharedMemorySize, LDS_BYTES) != hipSuccess) { fprintf(stderr, "kernel_launch: hipFuncSetAttribute failed\n"); grid = -1; return; }
        if (hipOccupancyMaxActiveBlocksPerMultiprocessor(&per_cu, (const void*)hyb_fwd, NWAVES * 64, LDS_BYTES) != hipSuccess || per_cu < 1) { fprintf(stderr, "kernel_launch: occupancy query says %d\n", per_cu); per_cu = 1; }
        (void)hipGetLastError();
        if (cus < 256) { fprintf(stderr, "kernel_launch: %d CUs: this kernel needs 256 co-resident workgroups (one per CU); nothing launched\n", cus); grid = -1; return; }
        grid = 256;
    }
    if (grid < 0) return;
    (void)hipMemsetAsync((char*)d_ws + WS_CTL, 0, CTL_ZERO_BYTES, stream);
    Args a{};
    for (int i = 0; i < 18; ++i) a.in[i] = (const float*)d_in[i];
    a.out = (float*)d_out; a.ws = (unsigned char*)d_ws;
#ifndef PROBE_PHASE
#define PROBE_PHASE -1
#endif
    if (PROBE_PHASE >= 0) {
        a.ph_lo = 0; a.ph_hi = PROBE_PHASE + 1; a.li = 0;
        hipLaunchKernelGGL(hyb_fwd, dim3(grid), dim3(NWAVES * 64), LDS_BYTES, stream, a);
        a.ph_lo = PROBE_PHASE; a.ph_hi = N_PHASES; a.li = 1;
        hipLaunchKernelGGL(hyb_fwd, dim3(grid), dim3(NWAVES * 64), LDS_BYTES, stream, a);
    } else if (MK_N_LAUNCHES == 1) {
        a.ph_lo = 0; a.ph_hi = N_PHASES; a.li = 0;
        hipLaunchKernelGGL(hyb_fwd, dim3(grid), dim3(NWAVES * 64), LDS_BYTES, stream, a);
    } else {
        for (int li = 0; li < N_PHASES; ++li) { a.ph_lo = li; a.ph_hi = li + 1; a.li = 0;
            hipLaunchKernelGGL(hyb_fwd, dim3(grid), dim3(NWAVES * 64), LDS_BYTES, stream, a); }
    }
}
```

```cpp
#include <hip/hip_runtime.h>
#include <type_traits>
#include <cstdio>
#include <cstdint>

#ifndef GEMM_SP2
#define GEMM_SP2 true
#endif
#ifndef GEMM_ALIGN
#define GEMM_ALIGN true
#endif
#ifndef P2_WGM
#define P2_WGM 4
#endif
#ifndef P8_WGM
#define P8_WGM 8
#endif
#ifndef P56_WGM
#define P56_WGM 4
#endif
#ifndef P9_WGM
#define P9_WGM 4
#endif
#ifndef MK_N_LAUNCHES
#define MK_N_LAUNCHES 1
#endif

namespace lay {
constexpr size_t MiB = 1u << 20, AR = 48 * MiB, DR = 16 * MiB;
constexpr size_t X1 = AR - 1 * MiB, X2 = AR - 2 * MiB, X4 = AR - 4 * MiB, X8 = AR - 8 * MiB, X32 = AR - 32 * MiB, XB = AR - 16384;
constexpr size_t D4 = DR - 4 * MiB, D8 = DR - 8 * MiB;
template <class T> __device__ __forceinline__ T* boff(T* p, size_t bytes) { return (T*)((char*)p + bytes); }
template <class T> __device__ __forceinline__ const T* boff(const T* p, size_t bytes) { return (const T*)((const char*)p + bytes); }
}
namespace pg8 {
#define PG8_LAS __attribute__((address_space(3)))
typedef unsigned short bf16_t;
typedef short bf16x8 __attribute__((ext_vector_type(8)));
typedef float f32x4 __attribute__((ext_vector_type(4)));
typedef unsigned u32x4 __attribute__((ext_vector_type(4)));
typedef float f32x2 __attribute__((ext_vector_type(2)));
typedef __bf16 bf16x2_t __attribute__((ext_vector_type(2)));
constexpr int BM = 256, BK = 64, HALF = 128, HTB = HALF * BK * 2, STAGE_BYTES = 8 * HTB, NXCD = 8;

__host__ __device__ __forceinline__ int lds_byte(int r, int c) { const int st = (r >> 4) * 2 + (c >> 5), rr = r & 15, cc = c & 31, ob = rr * 64 + cc * 2; return st * 1024 + (ob ^ (((ob >> 9) & 1) << 5)); }
__host__ __device__ __forceinline__ void stage_rc(int b, int& R, int& C) { const int st = b / 1024, sb = b % 1024, swz = sb ^ (((sb >> 9) & 1) << 5); R = (st >> 1) * 16 + swz / 64; C = (st & 1) * 32 + (swz % 64) / 2; }
__host__ __device__ __forceinline__ int perm32(int rho) { const int n = rho >> 4, i = rho & 15; return 8 * (i >> 2) + 4 * n + (i & 3); }

__device__ __forceinline__ size_t blk_off(int row, int col, int nkt) { return ((size_t)(row >> 7) * nkt + (col >> 6)) * 16384 + lds_byte(row & 127, col & 63); }
struct Unit { int pm, pn, seg; };
struct Gemm { const bf16_t *A0, *A1, *B0, *B1; int K; size_t xa0, xa1;
    __device__ __forceinline__ const char* a(int seg, int pm) const { return (const char*)(seg ? A1 : A0) + (size_t)(pm >> 3) * (seg ? xa1 : xa0); }
    __device__ __forceinline__ const char* b(int seg) const { return (const char*)(seg ? B1 : B0); }
    __device__ __forceinline__ int nt(int) const { return K / BK; } };
struct Gemm4 { const bf16_t *Ag, *A2, *A3, *Bg0, *Bg1, *B2, *B3; int Kg, Kb; size_t xag, xa2, xa3;
    __device__ __forceinline__ const char* a(int seg, int pm) const { return (const char*)(seg < 2 ? Ag : (seg == 2 ? A2 : A3)) + (size_t)(pm >> 3) * (seg < 2 ? xag : (seg == 2 ? xa2 : xa3)); }
    __device__ __forceinline__ const char* b(int seg) const { return (const char*)(seg == 0 ? Bg0 : (seg == 1 ? Bg1 : (seg == 2 ? B2 : B3))); }
    __device__ __forceinline__ int nt(int seg) const { return (seg < 2 ? Kg : Kb) / BK; } };

struct StaticOrder {
    int nM, nN, nwg, G, c, WGM; bool flip;
    __device__ void init(int M, int N, int G_, int c_, int wgm = 8, bool flip_ = false) { nM = M / BM; nN = N / BM; nwg = nM * nN; G = G_; c = c_; WGM = wgm; flip = flip_; }
    __device__ bool tile(int i, Unit& u) const {
        const long L = (long)i * G + c; if (L >= nwg) return false;
        int wgid = (int)L; { const int q = nwg / NXCD, r = nwg % NXCD, xcd = wgid % NXCD, off = wgid / NXCD; wgid = (xcd < r ? xcd * (q + 1) : r * (q + 1) + (xcd - r) * q) + off; }
        const int nig = WGM * nN, gid = wgid / nig, fm = gid * WGM, gsz = (nM - fm) < WGM ? (nM - fm) : WGM;
        u.pm = fm + ((wgid % nig) % gsz); u.pn = (wgid % nig) / gsz; if (flip) u.pn = nN - 1 - u.pn; return true;
    }
    static constexpr int NSEG = 1;
    __device__ bool tl(int i, Unit& u) const { return tile(i, u); }
};
struct DualOrder {
    StaticOrder b;
    static constexpr int NSEG = 2;
    __device__ bool tl(int i, Unit& u) const { return b.tile(i, u); }
};
struct QuadOrder {
    StaticOrder b;
    static constexpr int NSEG = 4;
    __device__ bool tl(int i, Unit& u) const { return b.tile(i, u); }
};

__device__ __forceinline__ unsigned cvtpk(float lo, float hi) { f32x2 v = {lo, hi}; bf16x2_t b = __builtin_convertvector(v, bf16x2_t); return __builtin_bit_cast(unsigned, b); }
__device__ __forceinline__ float bflo(unsigned w) { return __uint_as_float(w << 16); }
__device__ __forceinline__ float bfhi(unsigned w) { return __uint_as_float(w & 0xffff0000u); }
__device__ __forceinline__ float fast_exp(float x) { return __builtin_amdgcn_exp2f(x * 1.4426950408889634f); }
__device__ __forceinline__ float sigmoidf_(float x) { return __builtin_amdgcn_rcpf(1.0f + fast_exp(-x)); }


struct EpiProj {
    static constexpr bool PERM = true;
    bf16_t *QH, *VH, *GH, *AQ, *AK, *VT, *GHG, *GAT; float* LOGF; const float* lb; PG8_LAS unsigned char* tsc;
    __device__ __forceinline__ bool operator()(const f32x4 (&acc)[2][2][4][2], const Unit& u, int wr, int wc, int fr, int fq) const {
        const int pn = u.pn; const int row0 = u.pm * BM + wr * 64 + fr; const int cin = wc * 32 + 8 * fq;
        const size_t bb = (size_t)(u.pm >> 3);
        int mode, ldc, colt; bf16_t* base;
        if (pn < 4) { mode = 1; base = lay::boff(QH, bb * lay::X4); ldc = 1024; colt = pn * 256; }
        else if (pn < 8) { mode = 3; base = nullptr; ldc = 1024; colt = (pn - 4) * 256; }
        else if (pn < 12) { mode = 0; base = lay::boff(VH, bb * lay::X4); ldc = 1024; colt = (pn - 8) * 256; }
        else if (pn < 16) { mode = 1; base = lay::boff(GH, bb * lay::X4); ldc = 1024; colt = (pn - 12) * 256; }
        else if (pn < 20) { mode = 0; base = lay::boff(AQ, bb * lay::X4); ldc = 1024; colt = (pn - 16) * 256; }
        else if (pn == 20) { mode = 0; base = lay::boff(AK, bb * lay::X1); ldc = 256; colt = 0; }
        else if (pn == 21) { mode = 4; base = lay::boff(VT, bb * lay::X1); ldc = 0; colt = 0; }
        else if (pn < 30) { mode = 2; base = lay::boff(GHG, bb * lay::X8); ldc = 2048; colt = (pn - 22) * 256; }
        else { mode = 2; base = lay::boff(GAT, bb * lay::X8); ldc = 2048; colt = (pn - 30) * 256; }
        const int col0 = colt + cin;
        if (mode == 3) {
            f32x4 l0[2], l1[2];
#pragma unroll
            for (int bj = 0; bj < 2; ++bj) { l0[bj] = *(const f32x4*)(lb + col0 + bj * HALF); l1[bj] = *(const f32x4*)(lb + col0 + bj * HALF + 4); }
#pragma unroll
            for (int ai = 0; ai < 2; ++ai)
#pragma unroll
                for (int m = 0; m < 4; ++m) { float* rowp = lay::boff(LOGF, bb * lay::X8) + (size_t)(row0 + ai * HALF + m * 16) * 1024 + col0;
#pragma unroll
                    for (int bj = 0; bj < 2; ++bj) { const f32x4 v0 = acc[ai][bj][m][0], v1 = acc[ai][bj][m][1]; f32x4 o0, o1;
#pragma unroll
                        for (int e = 0; e < 4; ++e) { const float s0 = sigmoidf_(v0[e]), s1 = sigmoidf_(v1[e]);
                            o0[e] = __logf(l0[bj][e] + (1.0f - l0[bj][e]) * s0); o1[e] = __logf(l1[bj][e] + (1.0f - l1[bj][e]) * s1); }
                        *(f32x4*)(rowp + bj * HALF) = o0; *(f32x4*)(rowp + bj * HALF + 4) = o1; } }
            return false;
        }
        if (mode == 4) {
            typedef short v4i16_t __attribute__((ext_vector_type(4)));
            PG8_LAS unsigned char* sc = tsc + (wr * 4 + wc) * 1024;
            PG8_LAS unsigned char* wp = sc + fr * 64 + fq * 16;
            PG8_LAS unsigned char* rp = sc + (8 * (fq & 1) + (fr >> 2)) * 64 + (16 * (fq >> 1) + 4 * (fr & 3)) * 2;
#pragma unroll
            for (int ai = 0; ai < 2; ++ai)
#pragma unroll
                for (int m = 0; m < 4; ++m) { const int trow = u.pm * BM + wr * 64 + ai * HALF + m * 16 + 8 * (fq & 1); const int b = trow >> 11, t = trow & 2047;
#pragma unroll
                    for (int bj = 0; bj < 2; ++bj) { const f32x4 v0 = acc[ai][bj][m][0], v1 = acc[ai][bj][m][1];
                        u32x4 w; w.x = cvtpk(v0[0], v0[1]); w.y = cvtpk(v0[2], v0[3]); w.z = cvtpk(v1[0], v1[1]); w.w = cvtpk(v1[2], v1[3]);
                        *(PG8_LAS u32x4*)wp = w;
                        asm volatile("" ::: "memory");
                        const v4i16_t ta = __builtin_amdgcn_ds_read_tr16_b64_v4i16((PG8_LAS v4i16_t*)rp), tb = __builtin_amdgcn_ds_read_tr16_b64_v4i16((PG8_LAS v4i16_t*)(rp + 256));
                        asm volatile("" ::: "memory");
                        const int c = bj * HALF + wc * 32 + 16 * (fq >> 1) + fr;
                        typedef unsigned u32x2_t __attribute__((ext_vector_type(2)));
                        const u32x2_t xa = __builtin_bit_cast(u32x2_t, ta), xb = __builtin_bit_cast(u32x2_t, tb);
                        u32x4 o; o.x = xa.x; o.y = xa.y; o.z = xb.x; o.w = xb.y;
                        *(u32x4*)(base + ((size_t)(b * 256 + c)) * 2048 + t) = o; } }
            return false;
        }
#pragma unroll
        for (int ai = 0; ai < 2; ++ai)
#pragma unroll
            for (int m = 0; m < 4; ++m) { bf16_t* rowp = base + (size_t)(row0 + ai * HALF + m * 16) * ldc + col0;
#pragma unroll
                for (int bj = 0; bj < 2; ++bj) { f32x4 v0 = acc[ai][bj][m][0], v1 = acc[ai][bj][m][1];
                    if (mode != 0) {
#pragma unroll
                        for (int e = 0; e < 4; ++e) { const float s0 = sigmoidf_(v0[e]), s1 = sigmoidf_(v1[e]); v0[e] = (mode == 1) ? v0[e] * s0 : s0; v1[e] = (mode == 1) ? v1[e] * s1 : s1; } }
                    u32x4 w; w.x = cvtpk(v0[0], v0[1]); w.y = cvtpk(v0[2], v0[3]); w.z = cvtpk(v1[0], v1[1]); w.w = cvtpk(v1[2], v1[3]);
                    *(u32x4*)(rowp + bj * HALF) = w; } }
        return false;
    }
};

struct EpiMerge {
    static constexpr bool PERM = true;
    const bf16_t *GHG, *GAT; bf16_t* OUT;
    __device__ __forceinline__ bool operator()(f32x4 (&acc)[2][2][4][2], const Unit& u, int wr, int wc, int fr, int fq) const {
        const int row0 = u.pm * BM + wr * 64 + fr, col0 = u.pn * BM + wc * 32 + 8 * fq;
        const bf16_t* GHG = lay::boff(this->GHG, (size_t)(u.pm >> 3) * lay::X8); const bf16_t* GAT = lay::boff(this->GAT, (size_t)(u.pm >> 3) * lay::X8); bf16_t* OUT = lay::boff(this->OUT, (size_t)(u.pm >> 3) * lay::X8);
        if (u.seg == 0) {
#pragma unroll
            for (int ai = 0; ai < 2; ++ai)
#pragma unroll
                for (int m = 0; m < 4; ++m) { const size_t off = (size_t)(row0 + ai * HALF + m * 16) * 2048 + col0;
#pragma unroll
                    for (int bj = 0; bj < 2; ++bj) {
                        const u32x4 ga = *(const u32x4*)(GAT + off + bj * HALF); const u32x4 gh = *(const u32x4*)(GHG + off + bj * HALF);
                        f32x4 r0, r1;
                        r0[0] = bflo(gh.x) * __builtin_amdgcn_rcpf(bflo(ga.x)); r0[1] = bfhi(gh.x) * __builtin_amdgcn_rcpf(bfhi(ga.x));
                        r0[2] = bflo(gh.y) * __builtin_amdgcn_rcpf(bflo(ga.y)); r0[3] = bfhi(gh.y) * __builtin_amdgcn_rcpf(bfhi(ga.y));
                        r1[0] = bflo(gh.z) * __builtin_amdgcn_rcpf(bflo(ga.z)); r1[1] = bfhi(gh.z) * __builtin_amdgcn_rcpf(bfhi(ga.z));
                        r1[2] = bflo(gh.w) * __builtin_amdgcn_rcpf(bflo(ga.w)); r1[3] = bfhi(gh.w) * __builtin_amdgcn_rcpf(bfhi(ga.w));
                        acc[ai][bj][m][0] *= r0; acc[ai][bj][m][1] *= r1; } }
            return true;
        }
#pragma unroll
        for (int ai = 0; ai < 2; ++ai)
#pragma unroll
            for (int m = 0; m < 4; ++m) { const size_t off = (size_t)(row0 + ai * HALF + m * 16) * 2048 + col0;
#pragma unroll
                for (int bj = 0; bj < 2; ++bj) {
                    const u32x4 ga = *(const u32x4*)(GAT + off + bj * HALF);
                    const f32x4 v0 = acc[ai][bj][m][0], v1 = acc[ai][bj][m][1];
                    u32x4 w; w.x = cvtpk(v0[0] * bflo(ga.x), v0[1] * bfhi(ga.x)); w.y = cvtpk(v0[2] * bflo(ga.y), v0[3] * bfhi(ga.y));
                    w.z = cvtpk(v1[0] * bflo(ga.z), v1[1] * bfhi(ga.z)); w.w = cvtpk(v1[2] * bflo(ga.w), v1[3] * bfhi(ga.w));
                    *(u32x4*)((char*)OUT + blk_off(row0 + ai * HALF + m * 16, col0 + bj * HALF, 2048 / 64)) = w; } }
        return false;
    }
};

struct EpiResGate {
    static constexpr bool PERM = true;
    const float* base; const bf16_t* delta; float* out; const float* gate; int gstride;
    __device__ __forceinline__ bool operator()(const f32x4 (&acc)[2][2][4][2], const Unit& u, int wr, int wc, int fr, int fq) const {
        const int row0 = u.pm * BM + wr * 64 + fr, col0 = u.pn * BM + wc * 32 + 8 * fq;
        const float* gp = gate + (size_t)(row0 >> 11) * gstride + col0;
        const bf16_t* delta = lay::boff(this->delta, (size_t)(u.pm >> 3) * lay::X8);
        f32x4 g0[2], g1[2];
#pragma unroll
        for (int bj = 0; bj < 2; ++bj) { g0[bj] = *(const f32x4*)(gp + bj * HALF); g1[bj] = *(const f32x4*)(gp + bj * HALF + 4); }
#ifndef EPI9_PF
#define EPI9_PF 1
#endif
        f32x4 xb0[2][2][2], xb1[2][2][2]; u32x4 xd[2][2][2];
        auto ld = [&](int k, int s) __attribute__((always_inline)) {
#pragma unroll
            for (int mm = 0; mm < 2; ++mm) { const size_t off = (size_t)(row0 + (k >> 1) * HALF + ((k & 1) * 2 + mm) * 16) * 2048 + col0;
#pragma unroll
                for (int bj = 0; bj < 2; ++bj) { xb0[s][mm][bj] = __builtin_nontemporal_load((const f32x4*)(base + off + bj * HALF)); xb1[s][mm][bj] = __builtin_nontemporal_load((const f32x4*)(base + off + bj * HALF + 4));
                    xd[s][mm][bj] = *(const u32x4*)(delta + off + bj * HALF); } } };
        auto cs = [&](int k, int s) __attribute__((always_inline)) {
#pragma unroll
            for (int mm = 0; mm < 2; ++mm) { const int ai = k >> 1, m = (k & 1) * 2 + mm; const size_t off = (size_t)(row0 + ai * HALF + m * 16) * 2048 + col0;
#pragma unroll
                for (int bj = 0; bj < 2; ++bj) { const u32x4 dv = xd[s][mm][bj];
                    const f32x4 d0 = (f32x4){bflo(dv.x), bfhi(dv.x), bflo(dv.y), bfhi(dv.y)}, d1 = (f32x4){bflo(dv.z), bfhi(dv.z), bflo(dv.w), bfhi(dv.w)};
                    *(f32x4*)(out + off + bj * HALF) = (xb0[s][mm][bj] + d0) + g0[bj] * acc[ai][bj][m][0]; *(f32x4*)(out + off + bj * HALF + 4) = (xb1[s][mm][bj] + d1) + g1[bj] * acc[ai][bj][m][1]; } } };
#define SB9 __builtin_amdgcn_sched_barrier(0)
        if (EPI9_PF == 0) { ld(0, 0); SB9; cs(0, 0); SB9; ld(1, 0); SB9; cs(1, 0); SB9; ld(2, 0); SB9; cs(2, 0); SB9; ld(3, 0); SB9; cs(3, 0); SB9; }
        else {
            ld(0, 0); SB9; cs(0, 0); SB9; ld(1, 1); ld(2, 0); SB9; cs(1, 1); SB9; ld(3, 1); SB9; cs(2, 0); SB9; cs(3, 1); SB9; }
#undef SB9
        return false;
    }
};

struct EpiMerge4 {
    static constexpr bool PERM = true;
    bf16_t* SCR; bf16_t* OUT;
    __device__ __forceinline__ bool operator()(f32x4 (&acc)[2][2][4][2], const Unit& u, int wr, int wc, int fr, int fq) const {
        const int row0 = u.pm * BM + wr * 64 + fr, col0 = u.pn * BM + wc * 32 + 8 * fq;
        unsigned zo = 0; asm volatile("" : "+v"(zo));
        u32x4* sc = (u32x4*)((char*)SCR + zo) + (wr * 4 + wc) * 64 + fq * 16 + fr;
        if (u.seg < 2) {
            u32x4* dst = sc + u.seg * 8192;
#pragma unroll
            for (int ai = 0; ai < 2; ++ai)
#pragma unroll
                for (int m = 0; m < 4; ++m)
#pragma unroll
                    for (int bj = 0; bj < 2; ++bj) { f32x4 v0 = acc[ai][bj][m][0], v1 = acc[ai][bj][m][1];
#pragma unroll
                        for (int e = 0; e < 4; ++e) { v0[e] = sigmoidf_(v0[e]); v1[e] = sigmoidf_(v1[e]); }
                        u32x4 w; w.x = cvtpk(v0[0], v0[1]); w.y = cvtpk(v0[2], v0[3]); w.z = cvtpk(v1[0], v1[1]); w.w = cvtpk(v1[2], v1[3]);
                        dst[((ai * 4 + m) * 2 + bj) * 512] = w; }
            return false;
        }
        if (u.seg == 2) {
            u32x4 gh[2][2][2], ga[2][2][2];
            auto ldq = [&](int q, int sb) __attribute__((always_inline)) {
#pragma unroll
                for (int mm = 0; mm < 2; ++mm)
#pragma unroll
                    for (int bj = 0; bj < 2; ++bj) { const int pc = (((q >> 1) * 4 + (q & 1) * 2 + mm) * 2 + bj) * 512; gh[sb][mm][bj] = sc[pc]; ga[sb][mm][bj] = sc[8192 + pc]; } };
            ldq(0, 0);
#pragma unroll
            for (int q = 0; q < 4; ++q) { const int sb = q & 1, ai = q >> 1;
                if (q + 1 < 4) ldq(q + 1, sb ^ 1);
                __builtin_amdgcn_sched_barrier(0);
#pragma unroll
                for (int mm = 0; mm < 2; ++mm)
#pragma unroll
                    for (int bj = 0; bj < 2; ++bj) { const int m = (q & 1) * 2 + mm; const u32x4 h = gh[sb][mm][bj], a = ga[sb][mm][bj];
                        f32x4 r0, r1;
                        r0[0] = bflo(h.x) * __builtin_amdgcn_rcpf(bflo(a.x)); r0[1] = bfhi(h.x) * __builtin_amdgcn_rcpf(bfhi(a.x));
                        r0[2] = bflo(h.y) * __builtin_amdgcn_rcpf(bflo(a.y)); r0[3] = bfhi(h.y) * __builtin_amdgcn_rcpf(bfhi(a.y));
                        r1[0] = bflo(h.z) * __builtin_amdgcn_rcpf(bflo(a.z)); r1[1] = bfhi(h.z) * __builtin_amdgcn_rcpf(bfhi(a.z));
                        r1[2] = bflo(h.w) * __builtin_amdgcn_rcpf(bflo(a.w)); r1[3] = bfhi(h.w) * __builtin_amdgcn_rcpf(bfhi(a.w));
                        acc[ai][bj][m][0] *= r0; acc[ai][bj][m][1] *= r1; }
                { const int m0 = (q & 1) * 2;
                  asm volatile("" : "+v"(acc[ai][0][m0][0]), "+v"(acc[ai][0][m0][1]), "+v"(acc[ai][0][m0 + 1][0]), "+v"(acc[ai][0][m0 + 1][1]),
                                    "+v"(acc[ai][1][m0][0]), "+v"(acc[ai][1][m0][1]), "+v"(acc[ai][1][m0 + 1][0]), "+v"(acc[ai][1][m0 + 1][1]) :: "memory"); }
                __builtin_amdgcn_sched_barrier(0);
            }
            return true;
        }
        char* outb = (char*)OUT + (size_t)(u.pm >> 3) * lay::X8;
        u32x4 gav[2][4][2];
#pragma unroll
        for (int ai = 0; ai < 2; ++ai)
#pragma unroll
            for (int m = 0; m < 4; ++m)
#pragma unroll
                for (int bj = 0; bj < 2; ++bj) gav[ai][m][bj] = sc[8192 + ((ai * 4 + m) * 2 + bj) * 512];
        __builtin_amdgcn_sched_barrier(0);
#pragma unroll
        for (int ai = 0; ai < 2; ++ai)
#pragma unroll
            for (int m = 0; m < 4; ++m)
#pragma unroll
                for (int bj = 0; bj < 2; ++bj) { const u32x4 ga = gav[ai][m][bj];
                    const f32x4 v0 = acc[ai][bj][m][0], v1 = acc[ai][bj][m][1];
                    u32x4 w; w.x = cvtpk(v0[0] * bflo(ga.x), v0[1] * bfhi(ga.x)); w.y = cvtpk(v0[2] * bflo(ga.y), v0[3] * bfhi(ga.y));
                    w.z = cvtpk(v1[0] * bflo(ga.z), v1[1] * bfhi(ga.z)); w.w = cvtpk(v1[2] * bflo(ga.w), v1[3] * bfhi(ga.w));
                    *(u32x4*)(outb + blk_off(row0 + ai * HALF + m * 16, col0 + bj * HALF, 2048 / 64)) = w; }
        __builtin_amdgcn_sched_barrier(0);
        return false;
    }
};

struct EpiDelta {
    static constexpr bool PERM = true;
    bf16_t* O; const float* gate; int gstride;
    __device__ __forceinline__ bool operator()(const f32x4 (&acc)[2][2][4][2], const Unit& u, int wr, int wc, int fr, int fq) const {
        const int row0 = u.pm * BM + wr * 64 + fr, col0 = u.pn * BM + wc * 32 + 8 * fq;
        const float* gp = gate + (size_t)(row0 >> 11) * gstride + col0;
        f32x4 g0[2], g1[2];
#pragma unroll
        for (int bj = 0; bj < 2; ++bj) { g0[bj] = *(const f32x4*)(gp + bj * HALF); g1[bj] = *(const f32x4*)(gp + bj * HALF + 4); }
#pragma unroll
        for (int ai = 0; ai < 2; ++ai)
#pragma unroll
            for (int m = 0; m < 4; ++m) { bf16_t* rowp = lay::boff(O, (size_t)(u.pm >> 3) * lay::X8) + (size_t)(row0 + ai * HALF + m * 16) * 2048 + col0;
#pragma unroll
                for (int bj = 0; bj < 2; ++bj) { const f32x4 v0 = acc[ai][bj][m][0] * g0[bj], v1 = acc[ai][bj][m][1] * g1[bj];
                    u32x4 w; w.x = cvtpk(v0[0], v0[1]); w.y = cvtpk(v0[2], v0[3]); w.z = cvtpk(v1[0], v1[1]); w.w = cvtpk(v1[2], v1[3]);
                    *(u32x4*)(rowp + bj * HALF) = w; } }
        return false;
    }
};

struct EpiRelu2 {
    static constexpr bool PERM = true;
    bf16_t* O; int ldc;
    __device__ __forceinline__ bool operator()(const f32x4 (&acc)[2][2][4][2], const Unit& u, int wr, int wc, int fr, int fq) const {
        const int row0 = u.pm * BM + wr * 64 + fr, col0 = u.pn * BM + wc * 32 + 8 * fq;
#pragma unroll
        for (int ai = 0; ai < 2; ++ai)
#pragma unroll
            for (int m = 0; m < 4; ++m) { const int row = row0 + ai * HALF + m * 16;
#pragma unroll
                for (int bj = 0; bj < 2; ++bj) { f32x4 v0 = acc[ai][bj][m][0], v1 = acc[ai][bj][m][1];
#pragma unroll
                    for (int e = 0; e < 4; ++e) { const float r0 = fmaxf(v0[e], 0.f), r1 = fmaxf(v1[e], 0.f); v0[e] = r0 * r0; v1[e] = r1 * r1; }
                    u32x4 w; w.x = cvtpk(v0[0], v0[1]); w.y = cvtpk(v0[2], v0[3]); w.z = cvtpk(v1[0], v1[1]); w.w = cvtpk(v1[2], v1[3]);
                    __builtin_nontemporal_store(w, (u32x4*)((char*)O + (size_t)(u.pm >> 3) * lay::X32 + blk_off(row, col0 + bj * HALF, ldc / 64))); } }
        return false;
    }
};

template <class Epi, class Sched, bool ALIGN_EPI = false, bool SP2 = false, bool BLKB = true, bool BLKA = true, class GemmT = Gemm>
__device__ __forceinline__ void gemm_phase(PG8_LAS unsigned char* lds, const GemmT g, const Sched& S, const Epi& E) {
    const int tid = threadIdx.x, wid = __builtin_amdgcn_readfirstlane(tid >> 6), lane = tid & 63, wr = wid >> 2, wc = wid & 3, fr = lane & 15, fq = lane >> 4;
    static_assert(BLKA && BLKB, "operands are stored in LDS-image order");
    unsigned voffA[2], voffB[2];
#pragma unroll
    for (int i = 0; i < 2; ++i) { int R, C; stage_rc(tid * 16 + i * 8192, R, C); const int Rb = Epi::PERM ? ((R & ~31) + perm32(R & 31)) : R;
        (void)R; (void)C; (void)Rb; voffA[i] = (unsigned)(tid * 16 + i * 8192); voffB[i] = (unsigned)(tid * 16 + i * 8192); }
    const size_t kstep = BLKA ? (size_t)16384 : (size_t)(BK * 2);
    const size_t kstepB = BLKB ? (size_t)16384 : (size_t)(BK * 2);
    const unsigned ldsw = (unsigned)wid * 1024u;
    const int aoff = lds_byte(wr * 64 + fr, fq * 8), boff = lds_byte(wc * 32 + fr, fq * 8);
#define PG8_SA(b, h) (((b) * 2 + (h)) * HTB)
#define PG8_SB(b, h) ((4 + (b) * 2 + (h)) * HTB)
#define PG8_STAGE(bufoff, gbase, voff) do { _Pragma("unroll") for (int _i = 0; _i < 2; ++_i) \
        __builtin_amdgcn_global_load_lds((const unsigned*)((const char*)(gbase) + (voff)[_i]), (PG8_LAS unsigned*)(lds + (bufoff) + ldsw + _i * 8192), 16, 0, 0); } while (0)
#define PG8_LDA(dst, b, h) do { _Pragma("unroll") for (int m = 0; m < 4; ++m) _Pragma("unroll") for (int k = 0; k < 2; ++k) dst[m][k] = *(const PG8_LAS bf16x8*)(lds + PG8_SA(b, h) + aoff + m * 2048 + k * 1024); } while (0)
#define PG8_LDB(dst, b, h) do { _Pragma("unroll") for (int n = 0; n < 2; ++n) _Pragma("unroll") for (int k = 0; k < 2; ++k) dst[n][k] = *(const PG8_LAS bf16x8*)(lds + PG8_SB(b, h) + boff + n * 2048 + k * 1024); } while (0)
#define PG8_MMA(ai, bj, At, Bt) do { __builtin_amdgcn_s_setprio(1); _Pragma("unroll") for (int m = 0; m < 4; ++m) _Pragma("unroll") for (int n = 0; n < 2; ++n) _Pragma("unroll") for (int k = 0; k < 2; ++k) \
        acc[ai][bj][m][n] = __builtin_amdgcn_mfma_f32_16x16x32_bf16(Bt[n][k], At[m][k], acc[ai][bj][m][n], 0, 0, 0); __builtin_amdgcn_s_setprio(0); } while (0)
#define PG8_WAIT_V(n) asm volatile("s_waitcnt vmcnt(" #n ")" ::: "memory")
#define PG8_WAIT_L(n) asm volatile("s_waitcnt lgkmcnt(" #n ")" ::: "memory")
#define PG8_BAR __builtin_amdgcn_s_barrier()
#define PG8_SCHED __builtin_amdgcn_sched_barrier(0)
    Unit cur, nxt; int ti = 0;
    if (!S.tl(0, cur)) return;
    cur.seg = 0;
    f32x4 acc[2][2][4][2];
#pragma unroll
    for (int a = 0; a < 2; ++a)
#pragma unroll
        for (int b = 0; b < 2; ++b)
#pragma unroll
            for (int m = 0; m < 4; ++m)
#pragma unroll
                for (int n = 0; n < 2; ++n) acc[a][b][m][n] = (f32x4){0.f, 0.f, 0.f, 0.f};
    bf16x8 At[4][2], B0[2][2], B1[2][2];
    const char* cA; const char* cB;
    { const size_t hstep = (size_t)g.nt(0) * 16384;
    cA = g.a(0, cur.pm) + (size_t)cur.pm * (2 * hstep); cB = g.b(0) + (size_t)cur.pn * (2 * hstep);
    if constexpr (SP2) {
        PG8_STAGE(PG8_SB(0, 0), cB, voffB); PG8_STAGE(PG8_SB(0, 1), cB + hstep, voffB); PG8_STAGE(PG8_SA(0, 0), cA, voffA); PG8_STAGE(PG8_SA(0, 1), cA + hstep, voffA);
        PG8_STAGE(PG8_SB(1, 0), cB + kstepB, voffB); PG8_STAGE(PG8_SA(1, 0), cA + kstep, voffA); PG8_STAGE(PG8_SB(1, 1), cB + hstep + kstepB, voffB);
        if (wr == 1) PG8_BAR;
        PG8_WAIT_V(6); PG8_BAR; PG8_BAR;
    } else {
        PG8_STAGE(PG8_SB(0, 0), cB, voffB); PG8_STAGE(PG8_SA(0, 0), cA, voffA); PG8_STAGE(PG8_SB(0, 1), cB + hstep, voffB); PG8_STAGE(PG8_SA(0, 1), cA + hstep, voffA);
        if (wr == 1) PG8_BAR;
        PG8_WAIT_V(4); PG8_BAR;
        PG8_STAGE(PG8_SB(1, 0), cB + kstepB, voffB); PG8_STAGE(PG8_SA(1, 0), cA + kstep, voffA); PG8_STAGE(PG8_SB(1, 1), cB + hstep + kstepB, voffB);
        PG8_WAIT_V(6); PG8_BAR;
    } }
    auto unit = [&](auto segc) __attribute__((always_inline)) -> bool {
        constexpr int SEG = decltype(segc)::value, NXS = (SEG + 1) % Sched::NSEG;
        bool has_next = true;
        if constexpr (SEG + 1 < Sched::NSEG) nxt = cur; else has_next = S.tl(ti + 1, nxt);
        const int nt = g.nt(SEG), nnt = g.nt(NXS); const size_t hstep = (size_t)nt * 16384, nhstep = (size_t)nnt * 16384;
        const char* nA = has_next ? g.a(NXS, nxt.pm) + (size_t)nxt.pm * (2 * nhstep) : cA; const char* nB = has_next ? g.b(NXS) + (size_t)nxt.pn * (2 * nhstep) : cB;
        for (int t = 0; t < nt; t += 2) {
            const bool last = (t == nt - 2);
            const char* a1 = cA + (size_t)(t + 1) * kstep;
            const char* a2 = last ? nA : cA + (size_t)(t + 2) * kstep; const char* b2 = last ? nB : cB + (size_t)(t + 2) * kstepB;
            const char* a3 = a2 + kstep; const char* b3 = b2 + kstepB;
            const size_t h2 = last ? nhstep : hstep;
            if constexpr (SP2) {
            PG8_LDB(B0, 0, 0); PG8_LDB(B1, 0, 1); PG8_SCHED; PG8_LDA(At, 0, 0); PG8_STAGE(PG8_SA(1, 1), a1 + hstep, voffA);
            PG8_WAIT_V(8); PG8_WAIT_L(0); PG8_BAR; PG8_MMA(0, 0, At, B0); PG8_MMA(0, 1, At, B1); PG8_BAR; PG8_SCHED;
            PG8_LDA(At, 0, 1); PG8_STAGE(PG8_SB(0, 0), b2, voffB); PG8_STAGE(PG8_SB(0, 1), b2 + h2, voffB); PG8_STAGE(PG8_SA(0, 0), a2, voffA);
            PG8_WAIT_V(8); PG8_WAIT_L(0); PG8_BAR; PG8_MMA(1, 0, At, B0); PG8_MMA(1, 1, At, B1); PG8_BAR; PG8_SCHED;
            PG8_LDB(B0, 1, 0); PG8_LDB(B1, 1, 1); PG8_SCHED; PG8_LDA(At, 1, 0); PG8_STAGE(PG8_SA(0, 1), a2 + h2, voffA);
            PG8_WAIT_V(8); PG8_WAIT_L(0); PG8_BAR; PG8_MMA(0, 0, At, B0); PG8_MMA(0, 1, At, B1); PG8_BAR; PG8_SCHED;
            PG8_LDA(At, 1, 1); PG8_STAGE(PG8_SB(1, 0), b3, voffB); PG8_STAGE(PG8_SB(1, 1), b3 + h2, voffB); PG8_STAGE(PG8_SA(1, 0), a3, voffA);
            PG8_WAIT_V(8); PG8_WAIT_L(0); PG8_BAR; PG8_MMA(1, 0, At, B0); PG8_MMA(1, 1, At, B1); PG8_BAR; PG8_SCHED;
            } else {
            PG8_LDB(B0, 0, 0); PG8_SCHED; PG8_LDA(At, 0, 0); PG8_STAGE(PG8_SA(1, 1), a1 + hstep, voffA);
            PG8_WAIT_L(8); PG8_BAR; PG8_WAIT_L(0); PG8_MMA(0, 0, At, B0); PG8_BAR; PG8_SCHED;
            PG8_LDB(B1, 0, 1); PG8_STAGE(PG8_SB(0, 0), b2, voffB);
            PG8_BAR; PG8_WAIT_L(0); PG8_MMA(0, 1, At, B1); PG8_BAR;
            PG8_LDA(At, 0, 1); PG8_STAGE(PG8_SA(0, 0), a2, voffA);
            PG8_BAR; PG8_WAIT_L(0); PG8_MMA(1, 0, At, B0); PG8_BAR; PG8_SCHED;
            PG8_STAGE(PG8_SB(0, 1), b2 + h2, voffB);
            PG8_WAIT_V(6); PG8_BAR; PG8_MMA(1, 1, At, B1); PG8_BAR;
            PG8_LDB(B0, 1, 0); PG8_SCHED; PG8_LDA(At, 1, 0); PG8_STAGE(PG8_SA(0, 1), a2 + h2, voffA);
            PG8_WAIT_L(8); PG8_BAR; PG8_WAIT_L(0); PG8_MMA(0, 0, At, B0); PG8_BAR; PG8_SCHED;
            PG8_LDB(B1, 1, 1); PG8_STAGE(PG8_SB(1, 0), b3, voffB);
            PG8_BAR; PG8_WAIT_L(0); PG8_MMA(0, 1, At, B1); PG8_BAR;
            PG8_LDA(At, 1, 1); PG8_STAGE(PG8_SA(1, 0), a3, voffA);
            PG8_BAR; PG8_WAIT_L(0); PG8_MMA(1, 0, At, B0); PG8_BAR; PG8_SCHED;
            PG8_STAGE(PG8_SB(1, 1), b3 + h2, voffB);
            PG8_WAIT_V(6); PG8_BAR; PG8_MMA(1, 1, At, B1); PG8_BAR;
            }
        }
        if constexpr (ALIGN_EPI) { if (wr == 0) PG8_BAR; }
        Unit u = cur; u.seg = SEG;
        const bool keep = E(acc, u, wr, wc, fr, fq);
        if (!has_next) return false;
        if (!keep) {
#pragma unroll
        for (int a = 0; a < 2; ++a)
#pragma unroll
            for (int b = 0; b < 2; ++b)
#pragma unroll
                for (int m = 0; m < 4; ++m)
#pragma unroll
                    for (int n = 0; n < 2; ++n) acc[a][b][m][n] = (f32x4){0.f, 0.f, 0.f, 0.f};
        }
        cur = nxt; cA = nA; cB = nB; if constexpr (SEG + 1 == Sched::NSEG) ++ti;
        if constexpr (ALIGN_EPI) { if (wr == 1) PG8_BAR; }
        return true;
    };
    for (;;) {
        if (!unit(std::integral_constant<int, 0>{})) break;
        if constexpr (Sched::NSEG > 1) { if (!unit(std::integral_constant<int, 1>{})) break; }
        if constexpr (Sched::NSEG > 2) { if (!unit(std::integral_constant<int, 2>{})) break; if (!unit(std::integral_constant<int, 3>{})) break; }
    }
    PG8_WAIT_V(0);
    if constexpr (!ALIGN_EPI) { if (wr == 0) PG8_BAR; }
    PG8_BAR;
#undef PG8_SA
#undef PG8_SB
#undef PG8_STAGE
#undef PG8_LDA
#undef PG8_LDB
#undef PG8_MMA
#undef PG8_WAIT_V
#undef PG8_WAIT_L
#undef PG8_BAR
#undef PG8_SCHED
}
}

constexpr int NWAVES = 8;
constexpr int BATCH = 8, SEQ = 2048, DM = 2048, M = BATCH * SEQ;
constexpr int HGW = 1024, ATW = 1024, KVW = 256, INW = 4 * HGW + ATW + 2 * KVW + 2 * DM;
constexpr int DFF = 4 * DM;
constexpr float EPS = 1e-6f;
constexpr int N_PHASES = 10;

constexpr size_t MiB = 1u << 20;
constexpr size_t WS_CTL = 0, CTL_ZERO_BYTES = 128 * 1024;
constexpr size_t WS_ADA = 1 * MiB;
constexpr size_t WS_LB = WS_ADA + 512 * 1024;
constexpr size_t WS_BT = WS_LB + 4096;
constexpr size_t WS_WIN = 2 * MiB, WS_WBH = 40 * MiB, WS_WBA = 44 * MiB, WS_WOUT = 48 * MiB, WS_WFF1 = 56 * MiB, WS_WFF2 = 88 * MiB;
constexpr size_t WS_ARENA = 120 * MiB;
constexpr size_t AO_QH = 0, AO_VH = 4 * MiB, AO_LOGF = 8 * MiB, AO_GH = 16 * MiB, AO_AQ = 20 * MiB, AO_AK = 24 * MiB, AO_VT = 25 * MiB, AO_XN = 26 * MiB, AO_GSCR = 34 * MiB, AO_SLOC = 42 * MiB, AO_BSEG = 44 * MiB;
constexpr size_t AO_MERGED = 0;
constexpr size_t AO_H = 0, AO_XN2 = 32 * MiB, AO_D1 = 40 * MiB;
constexpr size_t WS_END = 504 * MiB;
constexpr int CW_BAR = 4096;
constexpr int CW_XCC = 15360;

constexpr int RING_OFF = 0, RING_BYTES = 131072;
constexpr int P0_SCR = 16640;
constexpr int LDSCTL_OFF = 8 * P0_SCR, MISC_OFF = LDSCTL_OFF + 320;
static_assert(LDSCTL_OFF >= RING_BYTES, "lds map");
constexpr int LDS_BYTES = 147456;
constexpr int VT_TSC_OFF = 134144;
static_assert(VT_TSC_OFF >= MISC_OFF + 256 && VT_TSC_OFF + 8192 <= LDS_BYTES, "V^T scratch");

#define GAS __attribute__((address_space(1)))
#define LAS __attribute__((address_space(3)))
typedef unsigned short bf16;
typedef unsigned v4u __attribute__((ext_vector_type(4)));
typedef unsigned v2u __attribute__((ext_vector_type(2)));
typedef float f32x4 __attribute__((ext_vector_type(4)));
typedef float f32x16 __attribute__((ext_vector_type(16)));
typedef short bf16x8 __attribute__((ext_vector_type(8)));
typedef short s16x4 __attribute__((ext_vector_type(4)));
#define LDS_WAIT() asm volatile("s_waitcnt lgkmcnt(0)" ::: "memory")
using pg8::cvtpk; using pg8::bflo; using pg8::bfhi; using pg8::fast_exp;
__device__ __forceinline__ unsigned f2bf(float f) { return pg8::cvtpk(f, 0.f) & 0xffffu; }
__device__ __forceinline__ float bf2f(unsigned short h) { return __uint_as_float((unsigned)h << 16); }

#define XB_TMO      128
#define XB_XCNT(j)  (256  + 64 * (j))
#define XB_XSUB(j)  (1280 + 64 * (j))
#define XB_XGEN(j)  (2304 + 64 * (j))
#define XB_TOP      3328
#define XB_TOPGEN   3392
#define XCD_BAR_WORDS 3456
#define XB_SPIN_CAP (1u << 18)
__device__ __forceinline__ unsigned xb_ld(unsigned* p)              { return __hip_atomic_load(p, __ATOMIC_RELAXED, __HIP_MEMORY_SCOPE_AGENT); }
__device__ __forceinline__ unsigned xb_add(unsigned* p, unsigned v) { return __hip_atomic_fetch_add(p, v, __ATOMIC_RELAXED, __HIP_MEMORY_SCOPE_AGENT); }
__device__ __forceinline__ unsigned xb_xcc_id() { return (unsigned)__builtin_amdgcn_s_getreg((3 << 11) | 20) & 0xFu; }
#define XB_SPIN(cond, bar) do { unsigned _sp = 0; while (cond) { __builtin_amdgcn_s_sleep(1); \
    if ((++_sp & 255u) == 0u) { if (xb_ld(&(bar)[XB_TMO])) break; if (_sp > XB_SPIN_CAP) { atomicAdd(&(bar)[XB_TMO], 1u); break; } } } } while (0)
struct XcdBarrier { unsigned* bar; unsigned x; volatile LAS unsigned* st; };
__device__ __forceinline__ XcdBarrier xcd_barrier_post(unsigned* bar, volatile LAS unsigned* st) {
    XcdBarrier b; b.bar = bar; b.x = xb_xcc_id(); b.st = st;
    if (threadIdx.x == 0) (void)xb_add(&bar[XB_XCNT(b.x)], 1u);
    return b;
}
__device__ __forceinline__ void xcd_barrier_complete(unsigned* bar, unsigned x, unsigned& nloc, unsigned& nx) {
    const unsigned G = gridDim.x * gridDim.y * gridDim.z;
    unsigned sum, cnt, mine, sp = 0u;
    for (;;) {
        sum = 0u; cnt = 0u; mine = 0u;
#pragma unroll
        for (unsigned j = 0; j < 16; ++j) { const unsigned c = xb_ld(&bar[XB_XCNT(j)]); sum += c; cnt += (c > 0u) ? 1u : 0u; mine = (j == x) ? c : mine; }
        if (sum == G) break;
        __builtin_amdgcn_s_sleep(1);
        if ((++sp & 255u) == 0u) { if (xb_ld(&bar[XB_TMO])) break; if (sp > XB_SPIN_CAP) { atomicAdd(&bar[XB_TMO], 1u); break; } }
    }
    nloc = mine > 0u ? mine : 1u; nx = cnt > 0u ? cnt : 1u;
}
__device__ __forceinline__ void xcd_barrier(const XcdBarrier& b) {
    asm volatile("s_waitcnt vmcnt(0)" ::: "memory");
    __syncthreads();
    if (threadIdx.x == 0) {
        unsigned* bar = b.bar;
        __builtin_amdgcn_s_waitcnt(0);
        unsigned nloc = b.st[0], nx = b.st[1];
        if (nloc == 0u) { xcd_barrier_complete(bar, b.x, nloc, nx); b.st[0] = nloc; b.st[1] = nx; }
        const unsigned old = xb_add(&bar[XB_XSUB(b.x)], 1u);
        const unsigned gen = old / nloc;
        if (old + 1u == (gen + 1u) * nloc) {
            __builtin_amdgcn_fence(__ATOMIC_RELEASE, "agent");
            asm volatile("s_waitcnt vmcnt(0)" ::: "memory");
            const unsigned og = xb_add(&bar[XB_TOP], 1u);
            const unsigned tg = og / nx;
            if (og + 1u == (tg + 1u) * nx) xb_add(&bar[XB_TOPGEN], 1u);
            else XB_SPIN(xb_ld(&bar[XB_TOPGEN]) == tg, bar);
            __builtin_amdgcn_fence(__ATOMIC_ACQUIRE, "agent");
            xb_add(&bar[XB_XGEN(b.x)], 1u);
            asm volatile("s_waitcnt vmcnt(0)" ::: "memory");
        } else {
            XB_SPIN(xb_ld(&bar[XB_XGEN(b.x)]) <= gen, bar);
            __builtin_amdgcn_fence(__ATOMIC_ACQUIRE, "agent");
            asm volatile("s_waitcnt vmcnt(0)" ::: "memory");
        }
    }
    __syncthreads();
}

__device__ __forceinline__ void xcd_barrier_local(const XcdBarrier& b) {
    asm volatile("s_waitcnt vmcnt(0)" ::: "memory");
    __syncthreads();
    if (threadIdx.x == 0) {
        unsigned* bar = b.bar;
        __builtin_amdgcn_s_waitcnt(0);
        unsigned nloc = b.st[0], nx = b.st[1];
        if (nloc == 0u) { xcd_barrier_complete(bar, b.x, nloc, nx); b.st[0] = nloc; b.st[1] = nx; }
        const unsigned old = xb_add(&bar[XB_XSUB(b.x)], 1u);
        const unsigned gen = old / nloc;
        if (old + 1u == (gen + 1u) * nloc) xb_add(&bar[XB_XGEN(b.x)], 1u);
        else XB_SPIN(xb_ld(&bar[XB_XSUB(b.x)]) < (gen + 1u) * nloc, bar);
        __builtin_amdgcn_fence(__ATOMIC_ACQUIRE, "agent");
        asm volatile("s_waitcnt vmcnt(0)" ::: "memory");
    }
    __syncthreads();
}

__device__ __forceinline__ unsigned xcd_barrier_local_arrive(const XcdBarrier& b) {
    asm volatile("s_waitcnt vmcnt(0)" ::: "memory");
    __syncthreads();
    unsigned tok = ~0u;
    if (threadIdx.x == 0) {
        unsigned* bar = b.bar;
        __builtin_amdgcn_s_waitcnt(0);
        unsigned nloc = b.st[0], nx = b.st[1];
        if (nloc == 0u) { xcd_barrier_complete(bar, b.x, nloc, nx); b.st[0] = nloc; b.st[1] = nx; }
        const unsigned old = xb_add(&bar[XB_XSUB(b.x)], 1u);
        const unsigned gen = old / nloc;
        if (old + 1u == (gen + 1u) * nloc) xb_add(&bar[XB_XGEN(b.x)], 1u); else tok = gen;
    }
    return tok;
}
__device__ __forceinline__ void xcd_barrier_local_wait(const XcdBarrier& b, unsigned tok) {
    if (threadIdx.x == 0) {
        unsigned* bar = b.bar;
        if (tok != ~0u) { const unsigned nloc = b.st[0]; XB_SPIN(xb_ld(&bar[XB_XSUB(b.x)]) < (tok + 1u) * nloc, bar); }
        __builtin_amdgcn_fence(__ATOMIC_ACQUIRE, "agent");
        asm volatile("s_waitcnt vmcnt(0)" ::: "memory");
    }
    __syncthreads();
}

__device__ __forceinline__ float wave_sum(float v) {
#pragma unroll
    for (int o = 1; o < 64; o <<= 1) v += __shfl_xor(v, o);
    return v;
}

struct Args { const float* in[18]; float* out; unsigned char* ws; int ph_lo, ph_hi, li, pad; };

struct TileD { const float* src; unsigned char* dst; int N, nh; };
__device__ __forceinline__ void tile_load(const TileD& d, f32x4 (&v)[16], int lane) {
    const int lr = lane >> 4, lc = 4 * (lane & 15);
#pragma unroll
    for (int i = 0; i < 16; ++i) v[i] = __builtin_nontemporal_load((const GAS f32x4*)(d.src + (size_t)(4 * i + lr) * d.N + lc));
}
__device__ __forceinline__ void tile_store(const TileD& d, const f32x4 (&v)[16], LAS float* scr, int lane) {
    const int lr = lane >> 4, lc = 4 * (lane & 15);
#pragma unroll
    for (int i = 0; i < 16; ++i) { LAS float* p = scr + (4 * i + lr) * 65 + lc; p[0] = v[i][0]; p[1] = v[i][1]; p[2] = v[i][2]; p[3] = v[i][3]; }
    LDS_WAIT(); asm volatile("" ::: "memory");
    const int c = lane & 7;
#pragma unroll
    for (int j = 0; j < 8; ++j) { const int n = (lane >> 3) + 8 * j; const LAS float* sp = scr + (8 * c) * 65 + n;
        v4u o; o.x = cvtpk(sp[0 * 65], sp[1 * 65]); o.y = cvtpk(sp[2 * 65], sp[3 * 65]); o.z = cvtpk(sp[4 * 65], sp[5 * 65]); o.w = cvtpk(sp[6 * 65], sp[7 * 65]);
        const int nn = d.nh + n, x = nn & 31, slot = (nn & ~31) + 16 * ((x >> 2) & 1) + 4 * (x >> 3) + (x & 3);
        *(GAS v4u*)(d.dst + pg8::lds_byte(slot, 8 * c)) = o; }
    LDS_WAIT(); asm volatile("" ::: "memory");
}
template <class D> __device__ __forceinline__ void transpose_items(const D& desc, int first, int stride, int end, LAS float* scr, int lane) {
    if (first >= end) return;
    const int last = first + ((end - 1 - first) / stride) * stride;
    f32x4 va[16], vb[16];
    int it = first; TileD a = desc(it), b; tile_load(a, va, lane);
    for (;;) {
        const int i2 = it + stride; b = desc(i2 < end ? i2 : last); tile_load(b, vb, lane);
        tile_store(a, va, scr, lane);
        if (i2 >= end) break;
        it = i2 + stride; a = desc(it < end ? it : last); tile_load(a, va, lane);
        tile_store(b, vb, scr, lane);
        if (it >= end) break;
    }
}
struct DescWin { const float* w; bf16* wt;
    __device__ __forceinline__ TileD operator()(int it) const { const int kb = it / (INW / 64), nb = it % (INW / 64); return TileD{w + (size_t)(64 * kb) * INW + 64 * nb, (unsigned char*)wt + ((size_t)(nb >> 1) * (DM / 64) + kb) * 16384, INW, (nb & 1) * 64}; } };
struct DescRest { const float *w_bh, *w_ba, *w_out, *w_ff1, *w_ff2; bf16 *WBH, *WBA, *WOUT, *WFF1, *WFF2;
    static constexpr int I_BH = (HGW / 64) * (DM / 64), I_OUT = (DM / 64) * (DM / 64), I_F1 = (DM / 64) * (DFF / 64), I_F2 = (DFF / 64) * (DM / 64), NITEMS = 2 * I_BH + I_OUT + I_F1 + I_F2;
    __device__ __forceinline__ TileD operator()(int it) const {
        const float* w; bf16* wt; int K, N, r = it;
        if (r < I_BH) { w = w_bh; wt = WBH; K = HGW; N = DM; }
        else if ((r -= I_BH) < I_BH) { w = w_ba; wt = WBA; K = ATW; N = DM; }
        else if ((r -= I_BH) < I_OUT) { w = w_out; wt = WOUT; K = DM; N = DM; }
        else if ((r -= I_OUT) < I_F1) { w = w_ff1; wt = WFF1; K = DM; N = DFF; }
        else { r -= I_F1; w = w_ff2; wt = WFF2; K = DFF; N = DM; }
        const int nblk = N / 64, kb = r / nblk, nb = r % nblk;
        return TileD{w + (size_t)(64 * kb) * N + 64 * nb, (unsigned char*)wt + ((size_t)(nb >> 1) * (K / 64) + kb) * 16384, N, (nb & 1) * 64}; } };

__device__ __forceinline__ void p0_ada(LAS unsigned char* lds, const float* c, const float* w_ada, const float* b_ada, float* ada, int blk, int tid) {
    LAS float* cact = (LAS float*)lds;
    LAS float* red = (LAS float*)(lds + 65536);
    { float cv[32];
#pragma unroll
      for (int q = 0; q < 32; ++q) cv[q] = c[tid + 512 * q];
#pragma unroll
      for (int q = 0; q < 32; ++q) { const int i = tid + 512 * q, b = i >> 11, k = i & 2047; const float x = cv[q]; cact[k * 8 + b] = x * pg8::sigmoidf_(x); } }
    __syncthreads();
    const int cq = tid & 15, kg = tid >> 4;
    f32x4 acc[8];
#pragma unroll
    for (int b = 0; b < 8; ++b) acc[b] = (f32x4){0.f, 0.f, 0.f, 0.f};
    const float* wp = w_ada + (size_t)kg * 12288 + 64 * blk + 4 * cq;
    const float bias_v = b_ada[64 * blk + (tid & 63)];
    f32x4 wb[2][8];
#pragma unroll
    for (int q = 0; q < 8; ++q) wb[0][q] = __builtin_nontemporal_load((const f32x4*)(wp + (size_t)q * 32 * 12288));
#pragma unroll
    for (int bt = 0; bt < 8; ++bt) {
        if (bt + 1 < 8) {
#pragma unroll
            for (int q = 0; q < 8; ++q) wb[(bt + 1) & 1][q] = __builtin_nontemporal_load((const f32x4*)(wp + (size_t)((bt + 1) * 8 + q) * 32 * 12288)); }
        __builtin_amdgcn_sched_barrier(0);
#pragma unroll
        for (int q = 0; q < 8; ++q) { const f32x4 w = wb[bt & 1][q];
            const int k = kg + 32 * (bt * 8 + q);
            const f32x4 c0 = *(const LAS f32x4*)(cact + k * 8), c1 = *(const LAS f32x4*)(cact + k * 8 + 4);
            acc[0] += w * c0[0]; acc[1] += w * c0[1]; acc[2] += w * c0[2]; acc[3] += w * c0[3];
            acc[4] += w * c1[0]; acc[5] += w * c1[1]; acc[6] += w * c1[2]; acc[7] += w * c1[3]; }
        __builtin_amdgcn_sched_barrier(0);
    }
#pragma unroll
    for (int b = 0; b < 8; ++b) *(LAS f32x4*)(red + (kg * 8 + b) * 64 + 4 * cq) = acc[b];
    __syncthreads();
    { const int b = tid >> 6, col = tid & 63; float s = 0.f;
#pragma unroll 8
      for (int g = 0; g < 32; ++g) s += red[(g * 8 + b) * 64 + col];
      ada[b * 12288 + 64 * blk + col] = s + bias_v; }
    __syncthreads();
}

namespace pg8n { struct NoHookN { __device__ __forceinline__ void operator()() const {} }; }
template <bool DELTA, class Hook>
__device__ __forceinline__ void norm_rows(LAS unsigned char* lds, const float* src, const bf16* delta, const float* g, const float* shift, const float* scale, bf16* dst, int bx, int wave, int lane, const Hook hook) {
    const int b = bx & 7, r0 = (bx >> 3) * NWAVES + wave;
    const float* shb = shift + b * 12288; const float* scb = scale + b * 12288;
    f32x4 xv[2][2][8]; v2u ev[2][2][8];
#define NR_LOADX(S, K) do { const int m0_ = b * SEQ + r0 + 256 * (K), m1_ = m0_ + 256; \
        const GAS f32x4* x0_ = (const GAS f32x4*)(src + (size_t)m0_ * DM) + lane; const GAS f32x4* x1_ = (const GAS f32x4*)(src + (size_t)m1_ * DM) + lane; \
        _Pragma("unroll") for (int j = 0; j < 8; ++j) { xv[S][0][j] = __builtin_nontemporal_load(&x0_[64 * j]); xv[S][1][j] = __builtin_nontemporal_load(&x1_[64 * j]); } } while (0)
#define NR_LOADD(S, K) do { if (DELTA) { const int m0_ = b * SEQ + r0 + 256 * (K), m1_ = m0_ + 256; \
            const GAS v2u* d0_ = (const GAS v2u*)(delta + (size_t)m0_ * DM) + lane; const GAS v2u* d1_ = (const GAS v2u*)(delta + (size_t)m1_ * DM) + lane; \
            _Pragma("unroll") for (int j = 0; j < 8; ++j) { ev[S][0][j] = d0_[64 * j]; ev[S][1][j] = d1_[64 * j]; } } } while (0)
#define NR_LOAD(S, K) do { NR_LOADX(S, K); NR_LOADD(S, K); } while (0)
    NR_LOADX(0, 0);
    { const int col = 4 * (wave * 64 + lane);
      const f32x4 tg = *(const f32x4*)(g + col), tsc = *(const f32x4*)(scb + col), tsh = *(const f32x4*)(shb + col);
      __builtin_amdgcn_sched_barrier(0);
      hook();
      NR_LOADD(0, 0);
      __builtin_amdgcn_sched_barrier(0);
      *(LAS f32x4*)(lds + col * 4) = tg * (tsc + 1.0f); *(LAS f32x4*)(lds + 8192 + col * 4) = tsh; }
    __syncthreads();
    auto step = [&](auto kc) __attribute__((always_inline)) {
        constexpr int k = decltype(kc)::value, s = (k >> 1) & 1;
        const int m0 = b * SEQ + r0 + 256 * k, m1 = m0 + 256;
        unsigned zo = 0; asm volatile("" : "+v"(zo));
        if (DELTA) {
#pragma unroll
            for (int j = 0; j < 8; ++j) {
#pragma unroll
                for (int q = 0; q < 2; ++q) { xv[s][q][j].x += bflo(ev[s][q][j].x); xv[s][q][j].y += bfhi(ev[s][q][j].x); xv[s][q][j].z += bflo(ev[s][q][j].y); xv[s][q][j].w += bfhi(ev[s][q][j].y); } }
        }
        if constexpr (k + 2 < 8) NR_LOAD(1 - s, k + 2);
        __builtin_amdgcn_sched_barrier(0);
        float s0 = 0.f, s1 = 0.f;
#pragma unroll
        for (int j = 0; j < 8; ++j) { const f32x4 p = xv[s][0][j], q = xv[s][1][j]; s0 += (p.x * p.x + p.y * p.y) + (p.z * p.z + p.w * p.w); s1 += (q.x * q.x + q.y * q.y) + (q.z * q.z + q.w * q.w); }
        const float ra = rsqrtf(wave_sum(s0) * (1.f / DM) + EPS), rb = rsqrtf(wave_sum(s1) * (1.f / DM) + EPS);
        GAS unsigned char* o0 = (GAS unsigned char*)dst + zo + ((size_t)(m0 >> 7) * (DM / 64)) * 16384; GAS unsigned char* o1 = (GAS unsigned char*)dst + zo + ((size_t)(m1 >> 7) * (DM / 64)) * 16384;
#pragma unroll
        for (int j = 0; j < 8; ++j) { const int col = 4 * lane + 256 * j;
            const f32x4 gmj = *(const LAS f32x4*)(lds + zo + col * 4), shj = *(const LAS f32x4*)(lds + zo + 8192 + col * 4);
            const f32x4 ya = (xv[s][0][j] * ra) * gmj + shj, yb = (xv[s][1][j] * rb) * gmj + shj;
            v2u wa, wb; wa.x = cvtpk(ya.x, ya.y); wa.y = cvtpk(ya.z, ya.w); wb.x = cvtpk(yb.x, yb.y); wb.y = cvtpk(yb.z, yb.w);
            *(GAS v2u*)(o0 + (size_t)(col >> 6) * 16384 + pg8::lds_byte(m0 & 127, col & 63)) = wa; *(GAS v2u*)(o1 + (size_t)(col >> 6) * 16384 + pg8::lds_byte(m1 & 127, col & 63)) = wb;
            if (j & 1) __builtin_amdgcn_sched_barrier(0); }
    };
    step(std::integral_constant<int, 0>{}); step(std::integral_constant<int, 2>{}); step(std::integral_constant<int, 4>{}); step(std::integral_constant<int, 6>{});
#undef NR_LOAD
#undef NR_LOADX
#undef NR_LOADD
    __syncthreads();
}

namespace hg {
constexpr int QS = 144, TS = 80;
constexpr int OFF_QT = 0, OFF_KT = 64 * QS * 2, OFF_KTT = 2 * OFF_KT, OFF_VT = OFF_KTT + 128 * TS * 2, OFF_P = OFF_VT + 128 * TS * 2, OFF_ST = OFF_P + 64 * TS * 2, OFF_SEG = OFF_ST + 128 * QS * 2, OFF_FAC = OFF_SEG + 4096, LDS_END = OFF_FAC + 1536;
static_assert(LDS_END <= RING_BYTES, "hgrn lds");
__device__ __forceinline__ bf16x8 ldfrag(const LAS unsigned char* base, int row, int stride, int k) { return *(const LAS bf16x8*)(base + (row * stride + k) * 2); }
#define MFMA16(a, b, c) __builtin_amdgcn_mfma_f32_16x16x32_bf16((a), (b), (c), 0, 0, 0)
typedef float f32x2 __attribute__((ext_vector_type(2)));

__device__ __forceinline__ void hgrn_seg(LAS unsigned char* lds, int bh, int j, const bf16* QH, const float* LOGF, const bf16* VH, bf16* OLOC, bf16* QC, float* SLOC, float* BSEG) {
    const int tid = threadIdx.x, lane = tid & 63, w = __builtin_amdgcn_readfirstlane(tid >> 6);
    const int b = bh >> 3, h = bh & 7;
    const int d0 = 2 * lane;
    const int l15 = lane & 15, lq = lane >> 4;
    LAS float* SEG = (LAS float*)(lds + OFF_SEG); LAS float* FAC = (LAS float*)(lds + OFF_FAC);
    const size_t colh = (size_t)h * 128;
    const size_t rowb = (size_t)b * SEQ + (size_t)j * 512;
    f32x2 lf[8]; unsigned qv[8], vv[8];
    { const size_t base = (rowb + 8 * w) * 1024 + colh + d0;
#pragma unroll
      for (int i = 0; i < 8; ++i) { lf[i] = *(const f32x2*)(LOGF + base + (size_t)i * 1024); qv[i] = *(const unsigned*)(QH + base + (size_t)i * 1024); vv[i] = *(const unsigned*)(VH + base + (size_t)i * 1024); } }
    f32x4 S[8];
#pragma unroll
    for (int i = 0; i < 8; ++i) S[i] = (f32x4){0.f, 0.f, 0.f, 0.f};
    const int tt = w & 3, vh = w >> 2;
    f32x2 coff = (f32x2){0.f, 0.f};

    for (int n = 0; n < 8; ++n) {
        { f32x2 run = (f32x2){0.f, 0.f};
#pragma unroll
          for (int i = 0; i < 8; ++i) run += lf[i];
          *(LAS f32x2*)(SEG + w * 128 + d0) = run; }
        __syncthreads();
        {
            f32x2 off = (f32x2){0.f, 0.f}, ref = (f32x2){0.f, 0.f}, blast = (f32x2){0.f, 0.f};
#pragma unroll
            for (int k = 0; k < 8; ++k) { const f32x2 sk = *(const LAS f32x2*)(SEG + k * 128 + d0); if (k < w) off += sk; if (k < 4) ref += sk; blast += sk; }
            if (w == 0) {
                *(LAS f32x2*)(FAC + d0) = (f32x2){fast_exp(ref.x), fast_exp(ref.y)};
                *(LAS f32x2*)(FAC + 128 + d0) = (f32x2){fast_exp(blast.x), fast_exp(blast.y)};
                *(LAS f32x2*)(FAC + 256 + d0) = (f32x2){fast_exp(blast.x - ref.x), fast_exp(blast.y - ref.y)}; }
            const float X0 = fast_exp(ref.x + coff.x), X1 = fast_exp(ref.y + coff.y);
            coff += blast;
            unsigned kA[4], kB[4], vA[4], vB[4];
            float E0 = fast_exp(off.x - ref.x), E1 = fast_exp(off.y - ref.y);
            bf16* qcp = QC + (rowb + 64 * n + 8 * w) * 1024 + colh + d0;
#pragma unroll
            for (int i = 0; i < 8; i += 2) {
                float kt[2][2];
#pragma unroll
                for (int e = 0; e < 2; ++e) {
                    const float f0 = fast_exp(lf[i + e].x), f1 = fast_exp(lf[i + e].y);
                    E0 *= f0; E1 *= f1;
                    const float q0 = bflo(qv[i + e]) * E0, q1 = bfhi(qv[i + e]) * E1;
                    kt[e][0] = (1.0f - f0) * __builtin_amdgcn_rcpf(E0); kt[e][1] = (1.0f - f1) * __builtin_amdgcn_rcpf(E1);
                    const int t = 8 * w + i + e;
                    *(LAS unsigned*)(lds + OFF_QT + (t * QS + d0) * 2) = cvtpk(q0, q1);
                    *(LAS unsigned*)(lds + OFF_KT + (t * QS + d0) * 2) = cvtpk(kt[e][0], kt[e][1]);
                    if (j > 0) *(unsigned*)(qcp + (size_t)(i + e) * 1024) = cvtpk(q0 * X0, q1 * X1);
                }
                kA[i >> 1] = cvtpk(kt[0][0], kt[1][0]); kB[i >> 1] = cvtpk(kt[0][1], kt[1][1]);
                vA[i >> 1] = (vv[i] & 0xffffu) | (vv[i + 1] << 16); vB[i >> 1] = (vv[i] >> 16) | (vv[i + 1] & 0xffff0000u);
            }
            *(LAS v4u*)(lds + OFF_KTT + (d0 * TS + 8 * w) * 2) = (v4u){kA[0], kA[1], kA[2], kA[3]};
            *(LAS v4u*)(lds + OFF_KTT + ((d0 + 1) * TS + 8 * w) * 2) = (v4u){kB[0], kB[1], kB[2], kB[3]};
            *(LAS v4u*)(lds + OFF_VT + (d0 * TS + 8 * w) * 2) = (v4u){vA[0], vA[1], vA[2], vA[3]};
            *(LAS v4u*)(lds + OFF_VT + ((d0 + 1) * TS + 8 * w) * 2) = (v4u){vB[0], vB[1], vB[2], vB[3]};
        }
        { const int nn = (n + 1 < 8) ? n + 1 : n;
          const size_t base = (rowb + 64 * nn + 8 * w) * 1024 + colh + d0;
#pragma unroll
            for (int i = 0; i < 8; ++i) { lf[i] = *(const f32x2*)(LOGF + base + (size_t)i * 1024); qv[i] = *(const unsigned*)(QH + base + (size_t)i * 1024); vv[i] = *(const unsigned*)(VH + base + (size_t)i * 1024); } }
        __syncthreads();
        {
            const int ti = w >> 1;
#pragma unroll
            for (int jj = 0; jj < 2; ++jj) { const int si = 2 * (w & 1) + jj; f32x4 a = (f32x4){0.f, 0.f, 0.f, 0.f};
                if (si <= ti) {
#pragma unroll
                    for (int ks = 0; ks < 4; ++ks) a = MFMA16(ldfrag(lds + OFF_KT, 16 * si + l15, QS, 32 * ks + 8 * lq), ldfrag(lds + OFF_QT, 16 * ti + l15, QS, 32 * ks + 8 * lq), a); }
                const int t = 16 * ti + l15, s0 = 16 * si + 4 * lq;
                v2u pw; pw.x = cvtpk(s0 <= t ? a[0] : 0.f, s0 + 1 <= t ? a[1] : 0.f); pw.y = cvtpk(s0 + 2 <= t ? a[2] : 0.f, s0 + 3 <= t ? a[3] : 0.f);
                *(LAS v2u*)(lds + OFF_P + (t * TS + s0) * 2) = pw; }
#pragma unroll
            for (int dt = 0; dt < 8; ++dt) { const f32x4 e = *(const LAS f32x4*)(FAC + 16 * dt + 4 * lq);
                S[dt] = S[dt] * e;
                v2u sw; sw.x = cvtpk(S[dt][0], S[dt][1]); sw.y = cvtpk(S[dt][2], S[dt][3]);
                *(LAS v2u*)(lds + OFF_ST + ((16 * w + l15) * QS + 16 * dt + 4 * lq) * 2) = sw; }
        }
        __syncthreads();
        {
            f32x4 o[4];
#pragma unroll
            for (int vt = 0; vt < 4; ++vt) o[vt] = (f32x4){0.f, 0.f, 0.f, 0.f};
#pragma unroll
            for (int ks = 0; ks < 2; ++ks) { const bf16x8 pb = ldfrag(lds + OFF_P, 16 * tt + l15, TS, 32 * ks + 8 * lq);
#pragma unroll
                for (int vt = 0; vt < 4; ++vt) o[vt] = MFMA16(ldfrag(lds + OFF_VT, 16 * (4 * vh + vt) + l15, TS, 32 * ks + 8 * lq), pb, o[vt]); }
#pragma unroll
            for (int ks = 0; ks < 4; ++ks) { const bf16x8 qb = ldfrag(lds + OFF_QT, 16 * tt + l15, QS, 32 * ks + 8 * lq);
#pragma unroll
                for (int vt = 0; vt < 4; ++vt) o[vt] = MFMA16(ldfrag(lds + OFF_ST, 16 * (4 * vh + vt) + l15, QS, 32 * ks + 8 * lq), qb, o[vt]); }
#pragma unroll
            for (int ks = 0; ks < 2; ++ks) { const bf16x8 vb = ldfrag(lds + OFF_VT, 16 * w + l15, TS, 32 * ks + 8 * lq);
#pragma unroll
                for (int dt = 0; dt < 8; ++dt) S[dt] = MFMA16(ldfrag(lds + OFF_KTT, 16 * dt + l15, TS, 32 * ks + 8 * lq), vb, S[dt]); }
#pragma unroll
            for (int dt = 0; dt < 8; ++dt) S[dt] = S[dt] * *(const LAS f32x4*)(FAC + 256 + 16 * dt + 4 * lq);
            bf16* op = OLOC + (rowb + 64 * n + 16 * tt + l15) * 1024 + colh + 64 * vh + 4 * lq;
#pragma unroll
            for (int vt = 0; vt < 4; ++vt) { v2u wv; wv.x = cvtpk(o[vt][0], o[vt][1]); wv.y = cvtpk(o[vt][2], o[vt][3]); *(v2u*)(op + 16 * vt) = wv; }
        }
    }
    { float* sp = SLOC + ((size_t)(bh * 4 + j) * 128 + 16 * w + l15) * 128 + 4 * lq;
#pragma unroll
      for (int dt = 0; dt < 8; ++dt) *(f32x4*)(sp + 16 * dt) = S[dt];
      if (w == 0) *(f32x2*)(BSEG + (size_t)(bh * 4 + j) * 128 + d0) = coff; }
    __syncthreads();
}

constexpr int OFF_SI = 0;
__device__ __forceinline__ void hgrn_fix(LAS unsigned char* lds, int bh, int j, const bf16* OLOC, const bf16* QC, const float* SLOC, const float* BSEG, const bf16* GH, const float* gout, bf16* OHG) {
    const int tid = threadIdx.x, lane = tid & 63, w = __builtin_amdgcn_readfirstlane(tid >> 6);
    const int b = bh >> 3, h = bh & 7;
    const int l15 = lane & 15, lq = lane >> 4;
    const size_t colh = (size_t)h * 128;
    const size_t rowb = (size_t)b * SEQ + (size_t)j * 512;
    f32x4 gg[8];
#pragma unroll
    for (int vt = 0; vt < 8; ++vt) gg[vt] = *(const f32x4*)(gout + 16 * vt + 4 * lq);
    v2u olA[8], gtA[8]; bf16x8 qbA[4];
    { const size_t rb_ = (rowb + 64 * w + l15) * 1024 + colh;
#pragma unroll
      for (int vt = 0; vt < 8; ++vt) { olA[vt] = *(const v2u*)(OLOC + rb_ + 16 * vt + 4 * lq); gtA[vt] = *(const v2u*)(GH + rb_ + 16 * vt + 4 * lq); }
      if (j > 0) {
#pragma unroll
          for (int ks = 0; ks < 4; ++ks) qbA[ks] = *(const bf16x8*)(QC + rb_ + 32 * ks + 8 * lq); } }
    if (j > 0) {
        const int v = tid >> 2, dq = 32 * (tid & 3);
        f32x4 a[8], bsv[8], slv[8];
        { const float* sp = SLOC + ((size_t)(bh * 4) * 128 + v) * 128 + dq;
#pragma unroll
          for (int i = 0; i < 8; ++i) a[i] = *(const f32x4*)(sp + 4 * i); }
        if (j > 1) {
            const float* sp = SLOC + ((size_t)(bh * 4 + 1) * 128 + v) * 128 + dq; const float* bp = BSEG + (size_t)(bh * 4 + 1) * 128 + dq;
#pragma unroll
            for (int i = 0; i < 8; ++i) { bsv[i] = *(const f32x4*)(bp + 4 * i); slv[i] = *(const f32x4*)(sp + 4 * i); }
        }
        __builtin_amdgcn_sched_barrier(0);
        for (int sg = 1; sg < j; ++sg) {
            if (sg > 1) { const float* sp = SLOC + ((size_t)(bh * 4 + sg) * 128 + v) * 128 + dq; const float* bp = BSEG + (size_t)(bh * 4 + sg) * 128 + dq;
#pragma unroll
                for (int i = 0; i < 8; ++i) { bsv[i] = *(const f32x4*)(bp + 4 * i); slv[i] = *(const f32x4*)(sp + 4 * i); } }
#pragma unroll
            for (int i = 0; i < 8; ++i) { const f32x4 bs = bsv[i], sl = slv[i];
                a[i][0] = a[i][0] * fast_exp(bs[0]) + sl[0]; a[i][1] = a[i][1] * fast_exp(bs[1]) + sl[1]; a[i][2] = a[i][2] * fast_exp(bs[2]) + sl[2]; a[i][3] = a[i][3] * fast_exp(bs[3]) + sl[3]; }
        }
#pragma unroll
        for (int i = 0; i < 8; i += 2) { v4u wv; wv.x = cvtpk(a[i][0], a[i][1]); wv.y = cvtpk(a[i][2], a[i][3]); wv.z = cvtpk(a[i + 1][0], a[i + 1][1]); wv.w = cvtpk(a[i + 1][2], a[i + 1][3]);
            *(LAS v4u*)(lds + OFF_SI + (v * QS + dq + 4 * i) * 2) = wv; }
    }
    __syncthreads();
#define FIX_LOAD(I4, OL, GT, QB) do { const size_t rb_ = (rowb + 64 * w + 16 * (I4) + l15) * 1024 + colh; \
        _Pragma("unroll") for (int vt = 0; vt < 8; ++vt) { OL[vt] = *(const v2u*)(OLOC + rb_ + 16 * vt + 4 * lq); GT[vt] = *(const v2u*)(GH + rb_ + 16 * vt + 4 * lq); } \
        if (j > 0) { _Pragma("unroll") for (int ks = 0; ks < 4; ++ks) QB[ks] = *(const bf16x8*)(QC + rb_ + 32 * ks + 8 * lq); } } while (0)
#define FIX_PROC(I4, OL, GT, QB) do { const int t = 64 * w + 16 * (I4) + l15; \
        f32x4 o[8]; \
        _Pragma("unroll") for (int vt = 0; vt < 8; ++vt) o[vt] = (f32x4){0.f, 0.f, 0.f, 0.f}; \
        if (j > 0) { _Pragma("unroll") for (int ks = 0; ks < 4; ++ks) { _Pragma("unroll") for (int vt = 0; vt < 8; ++vt) o[vt] = MFMA16(ldfrag(lds + OFF_SI, 16 * vt + l15, QS, 32 * ks + 8 * lq), QB[ks], o[vt]); } } \
        float ss = 0.f; \
        _Pragma("unroll") for (int vt = 0; vt < 8; ++vt) { o[vt][0] += bflo(OL[vt].x); o[vt][1] += bfhi(OL[vt].x); o[vt][2] += bflo(OL[vt].y); o[vt][3] += bfhi(OL[vt].y); \
            ss += (o[vt][0] * o[vt][0] + o[vt][1] * o[vt][1]) + (o[vt][2] * o[vt][2] + o[vt][3] * o[vt][3]); } \
        ss += __shfl_xor(ss, 16); ss += __shfl_xor(ss, 32); \
        const float r = rsqrtf(ss * (1.f / 128.f) + EPS); \
        _Pragma("unroll") for (int vt = 0; vt < 8; ++vt) { v2u wv; \
            wv.x = cvtpk(o[vt][0] * r * gg[vt][0] * bflo(GT[vt].x), o[vt][1] * r * gg[vt][1] * bfhi(GT[vt].x)); \
            wv.y = cvtpk(o[vt][2] * r * gg[vt][2] * bflo(GT[vt].y), o[vt][3] * r * gg[vt][3] * bfhi(GT[vt].y)); \
            *(v2u*)((char*)OHG + pg8::blk_off((int)(rowb + t), (int)colh + 16 * vt + 4 * lq, HGW / 64)) = wv; } } while (0)
    { v2u olB[8], gtB[8]; bf16x8 qbB[4];
      FIX_LOAD(1, olB, gtB, qbB);
      FIX_PROC(0, olA, gtA, qbA); FIX_LOAD(2, olA, gtA, qbA);
      FIX_PROC(1, olB, gtB, qbB); FIX_LOAD(3, olB, gtB, qbB);
      FIX_PROC(2, olA, gtA, qbA);
      FIX_PROC(3, olB, gtB, qbB); }
#undef FIX_LOAD
#undef FIX_PROC
    __syncthreads();
}
}

namespace at {
#define MFMA32(a, b, c) __builtin_amdgcn_mfma_f32_32x32x16_bf16((a), (b), (c), 0, 0, 0)
__device__ __forceinline__ int crow(int r, int hi) { return (r & 3) + 8 * (r >> 2) + 4 * hi; }
constexpr float NEG = -1e30f;
constexpr float L2E = 1.4426950408889634f;
constexpr int KS = 72, VS = 264;
constexpr int OFF_K = 0, OFF_V = 256 * KS * 2  , OFF_BT = OFF_V + 64 * VS * 2  , BTS = 192, OFF_QK = OFF_BT + 16 * BTS * 4, LDS_END = OFF_QK + 256;
static_assert(LDS_END <= RING_BYTES, "attn lds");
__device__ __forceinline__ void attn_unit(LAS unsigned char* lds, int unit, const bf16* AQ, const bf16* AK, const bf16* VT, bf16* OAT, const float* qg, const float* kg, const float* sinks, const float* BT) {
    const int tid = threadIdx.x, lane = tid & 63, r = lane & 31, hh = lane >> 5, w = __builtin_amdgcn_readfirstlane(tid >> 6);
    const int nq = unit & 15, kvh = (unit >> 4) & 3, b = unit >> 6;
    const int kbase = 128 * (nq - 1);
    v4u qraw[4];
    { const int g0 = w >> 1, h0 = kvh * 4 + g0, qi0 = 2 * (w & 1);
      const bf16* qp = AQ + (size_t)(b * SEQ + 128 * nq + 32 * qi0 + r) * 1024 + h0 * 64 + 8 * hh;
#pragma unroll
      for (int ks = 0; ks < 4; ++ks) qraw[ks] = *(const v4u*)(qp + 16 * ks); }
    const float sink_raw = sinks[kvh * 4 + (w >> 1)];
    { const int c = tid & 7, cv = tid & 31;
      v4u kraw[4], vraw[4];
#pragma unroll
      for (int p = 0; p < 4; ++p) { const int key = 64 * p + (tid >> 3); const int kk = (kbase + key) < 0 ? 0 : (kbase + key);
          kraw[p] = *(const v4u*)(AK + (size_t)(b * SEQ + kk) * 256 + kvh * 64 + 8 * c); }
#pragma unroll
      for (int p = 0; p < 4; ++p) { const int d = 16 * p + (tid >> 5); const int tk = (kbase + 8 * cv) < 0 ? 0 : (kbase + 8 * cv);
          vraw[p] = *(const v4u*)(VT + (size_t)((b * 4 + kvh) * 64 + d) * SEQ + tk); }
      if (BT != nullptr) {
          static_assert(16 * BTS == 6 * 512, "bias table fill");
          LAS float* bt = (LAS float*)(lds + OFF_BT);
          float btv[6];
#pragma unroll
          for (int k = 0; k < 6; ++k) { const int i = tid + 512 * k, hd = i / BTS, e = i % BTS - 32; btv[k] = BT[hd * 128 + (e < 0 ? 0 : (e > 127 ? 127 : e))]; }
          const float qkv = qg[tid & 63] * kg[tid & 63];
#pragma unroll
          for (int k = 0; k < 6; ++k) { const int i = tid + 512 * k, e = i % BTS - 32; bt[i] = (e >= 0 && e < 128) ? btv[k] * L2E : NEG; }
          if (tid < 64) ((LAS float*)(lds + OFF_QK))[tid] = qkv * (0.125f * L2E);
      }
      __builtin_amdgcn_sched_barrier(0);
#pragma unroll
      for (int p = 0; p < 4; ++p) { const int key = 64 * p + (tid >> 3); const v4u raw = kraw[p];
          float ss = 0.f;
#pragma unroll
          for (int e = 0; e < 4; ++e) { const float a0 = bflo(raw[e]), a1 = bfhi(raw[e]); ss += a0 * a0 + a1 * a1; }
          ss += __shfl_xor(ss, 1); ss += __shfl_xor(ss, 2); ss += __shfl_xor(ss, 4);
          const float rk = rsqrtf(ss * (1.f / 64.f) + EPS);
          v4u o;
#pragma unroll
          for (int e = 0; e < 4; ++e) o[e] = cvtpk(bflo(raw[e]) * rk, bfhi(raw[e]) * rk);
          *(LAS v4u*)(lds + OFF_K + (key * KS + 8 * c) * 2) = o; }
#pragma unroll
      for (int p = 0; p < 4; ++p) { const int d = 16 * p + (tid >> 5); *(LAS v4u*)(lds + OFF_V + (d * VS + 8 * cv) * 2) = vraw[p]; } }
    __syncthreads();
    const int g = w >> 1, h = kvh * 4 + g;
    const LAS float* qk = (const LAS float*)(lds + OFF_QK);
    const float sink = sink_raw * L2E;
    const LAS float* btl = (const LAS float*)(lds + OFF_BT) + h * BTS + r - 4 * hh;
#pragma unroll 1
    for (int qq = 0; qq < 2; ++qq) {
        const int qi = 2 * (w & 1) + qq;
        const int t0 = 128 * nq + 32 * qi;
        const int kt_lo = (nq == 0) ? 4 - qi : 0;
        bf16x8 qf[4];
        { v4u raw[4]; float ss = 0.f;
#pragma unroll
          for (int ks = 0; ks < 4; ++ks) { raw[ks] = qraw[ks];
#pragma unroll
              for (int e = 0; e < 4; ++e) { const float a0 = bflo(raw[ks][e]), a1 = bfhi(raw[ks][e]); ss += a0 * a0 + a1 * a1; } }
          ss += __shfl_xor(ss, 32);
          const float rq = rsqrtf(ss * (1.f / 64.f) + EPS);
#pragma unroll
          for (int ks = 0; ks < 4; ++ks) { v4u o; const f32x4 s0 = *(const LAS f32x4*)(qk + 16 * ks + 8 * hh), s1 = *(const LAS f32x4*)(qk + 16 * ks + 8 * hh + 4);
              o[0] = cvtpk(bflo(raw[ks][0]) * rq * s0[0], bfhi(raw[ks][0]) * rq * s0[1]); o[1] = cvtpk(bflo(raw[ks][1]) * rq * s0[2], bfhi(raw[ks][1]) * rq * s0[3]);
              o[2] = cvtpk(bflo(raw[ks][2]) * rq * s1[0], bfhi(raw[ks][2]) * rq * s1[1]); o[3] = cvtpk(bflo(raw[ks][3]) * rq * s1[2], bfhi(raw[ks][3]) * rq * s1[3]);
              qf[ks] = __builtin_bit_cast(bf16x8, o); } }
        f32x16 Sv[5];
#pragma unroll
        for (int kt = 0; kt < 5; ++kt) {
            if (kt >= kt_lo) {
                const LAS unsigned char* kp = lds + OFF_K + ((32 * (qi + kt) + r) * KS + 8 * hh) * 2;
                f32x16 a;
#pragma unroll
                for (int i = 0; i < 16; ++i) { const int cst = 128 - 32 * kt - (i & 3) - 8 * (i >> 2); a[i] = btl[32 + cst]; }
#pragma unroll
                for (int ks = 0; ks < 4; ++ks) a = MFMA32(*(const LAS bf16x8*)(kp + 32 * ks), qf[ks], a);
                Sv[kt] = a;
                if (kt == 2) __builtin_amdgcn_sched_barrier(0);
            } else {
#pragma unroll
                for (int i = 0; i < 16; ++i) Sv[kt][i] = NEG;
            }
        }
        float mx = sink;
#pragma unroll
        for (int kt = 0; kt < 5; ++kt)
#pragma unroll
            for (int i = 0; i < 16; ++i) mx = fmaxf(mx, Sv[kt][i]);
        mx = fmaxf(mx, __shfl_xor(mx, 32));
        float l = 0.f;
#pragma unroll
        for (int kt = 0; kt < 5; ++kt)
#pragma unroll
            for (int i = 0; i < 16; ++i) { const float p = __builtin_amdgcn_exp2f(Sv[kt][i] - mx); Sv[kt][i] = p; l += p; }
        l += __shfl_xor(l, 32);
        l += __builtin_amdgcn_exp2f(sink - mx);
        const float inv = 1.0f / l;
        { const bf16* qp = AQ + (size_t)(b * SEQ + t0 + 32 * (1 - qq) + r) * 1024 + h * 64 + 8 * hh;
#pragma unroll
          for (int ks = 0; ks < 4; ++ks) qraw[ks] = *(const v4u*)(qp + 16 * ks); }
        f32x16 O[2];
#pragma unroll
        for (int i = 0; i < 16; ++i) { O[0][i] = 0.f; O[1][i] = 0.f; }
#pragma unroll
        for (int kt = 0; kt < 5; ++kt) {
            if (kt >= kt_lo) {
#pragma unroll
                for (int s2 = 0; s2 < 2; ++s2) {
                    v4u pw;
#pragma unroll
                    for (int e = 0; e < 4; ++e) pw[e] = cvtpk(Sv[kt][8 * s2 + 2 * e], Sv[kt][8 * s2 + 2 * e + 1]);
                    const bf16x8 pb = __builtin_bit_cast(bf16x8, pw);
#pragma unroll
                    for (int dt = 0; dt < 2; ++dt) { const LAS unsigned char* vp = lds + OFF_V + ((32 * dt + r) * VS + 32 * (qi + kt) + 16 * s2 + 4 * hh) * 2;
                        const v2u lo = *(const LAS v2u*)(vp), hi = *(const LAS v2u*)(vp + 16);
                        const v4u va = (v4u){lo.x, lo.y, hi.x, hi.y};
                        O[dt] = MFMA32(__builtin_bit_cast(bf16x8, va), pb, O[dt]); }
                }
                if (kt & 1) __builtin_amdgcn_sched_barrier(0);
            }
        }
#pragma unroll
        for (int dt = 0; dt < 2; ++dt)
#pragma unroll
            for (int g4 = 0; g4 < 4; ++g4) { v2u wv; wv.x = cvtpk(O[dt][4 * g4] * inv, O[dt][4 * g4 + 1] * inv); wv.y = cvtpk(O[dt][4 * g4 + 2] * inv, O[dt][4 * g4 + 3] * inv);
                *(v2u*)((char*)OAT + pg8::blk_off(b * SEQ + t0 + r, h * 64 + 4 * hh + 32 * dt + 8 * g4, ATW / 64)) = wv; }
    }
    __syncthreads();
}
}

__global__ void __launch_bounds__(NWAVES * 64, 2) hyb_fwd(Args args) {
    extern __shared__ __attribute__((aligned(16))) unsigned char lds_raw[];
    LAS unsigned char* lds = (LAS unsigned char*)lds_raw;
    volatile LAS unsigned* MISC = (volatile LAS unsigned*)(lds + MISC_OFF);
    const int tid = threadIdx.x, lane = tid & 63, wave = __builtin_amdgcn_readfirstlane(tid >> 6);
    const int G = gridDim.x; const int bx = blockIdx.x; const int vcu = (G % 8 == 0) ? (bx % 8) * (G / 8) + bx / 8 : bx;
    unsigned char* ws = args.ws;
    unsigned* ctl = (unsigned*)(ws + WS_CTL);
    for (int u = tid; u < (LDS_BYTES - LDSCTL_OFF) / 4; u += NWAVES * 64) ((LAS unsigned*)(lds + LDSCTL_OFF))[u] = 0u;
    __syncthreads();
    XcdBarrier bar; bar.bar = ctl + CW_BAR + args.li * XCD_BAR_WORDS; bar.x = 0; bar.st = nullptr;
    if (MK_N_LAUNCHES != N_PHASES) bar = xcd_barrier_post(ctl + CW_BAR + args.li * XCD_BAR_WORDS, MISC + 8);
#ifndef LOCAL_SEAMS
#define LOCAL_SEAMS 0x1fa
#endif
    unsigned* xcctab = ctl + CW_XCC + args.li * 256;
    if (MK_N_LAUNCHES != N_PHASES && tid == 0) __hip_atomic_store(xcctab + bx, xb_xcc_id() + 1u, __ATOMIC_RELAXED, __HIP_MEMORY_SCOPE_AGENT);
    int canon = -1;
#define GRID_BAR_FULL() do { if (MK_N_LAUNCHES != N_PHASES) { xcd_barrier(bar); \
        if (canon < 0) { if (wave == 0) { \
                unsigned me_[4]; for (int q_ = 0; q_ < 4; ++q_) me_[q_] = __hip_atomic_load(xcctab + lane + 64 * q_, __ATOMIC_RELAXED, __HIP_MEMORY_SCOPE_AGENT);     \
                const unsigned rep_ = __hip_atomic_load(xcctab + (lane & 7), __ATOMIC_RELAXED, __HIP_MEMORY_SCOPE_AGENT);                                             \
                bool ok = (G == 256) & (rep_ != 0u) & (me_[0] == rep_) & (me_[1] == rep_) & (me_[2] == rep_) & (me_[3] == rep_); \
                for (int o_ = 1; o_ < 8; ++o_) ok = ok & (rep_ != (unsigned)__shfl(rep_, (lane + o_) & 7));                                                          \
                ok = __all(ok); if (lane == 0) MISC[11] = ok ? 1u : 0u; } \
            __syncthreads(); canon = (int)MISC[11]; } } } while (0)
#define GRID_BAR(k) do { if (MK_N_LAUNCHES != N_PHASES) { if (((LOCAL_SEAMS >> (k)) & 1) && canon == 1) xcd_barrier_local(bar); else GRID_BAR_FULL(); } } while (0)
    const int lo = args.ph_lo, hi = args.ph_hi;
#ifndef PH_MASK
#define PH_MASK 0xfff
#endif
#ifndef P3_MASK
#define P3_MASK 3
#endif
#define IN(k) (((PH_MASK >> (k)) & 1) && lo <= (k) && (k) < hi)
#define BOTH(k) (IN(k) && IN((k) + 1))
#ifndef REP_MASK
#define REP_MASK 0
#endif
#define REP(k) for (int rep_ = 0; rep_ < (((REP_MASK >> (k)) & 1) ? 2 : 1); ++rep_)
#define SEAM(k) do { if (BOTH(k) || rep_ == 0 && ((REP_MASK >> (k)) & 1)) GRID_BAR(k); } while (0)
    const float* x = args.in[0]; const float* c = args.in[1]; const float* w_ada = args.in[2]; const float* b_ada = args.in[3];
    const float* norm1_g = args.in[4]; const float* norm2_g = args.in[5]; const float* w_in = args.in[6]; const float* lb_logits = args.in[7];
    const float* hg_out_g = args.in[8]; const float* q_norm_g = args.in[9]; const float* k_norm_g = args.in[10]; const float* sinks = args.in[11];
    const float* rel_bias = args.in[12]; const float* w_bh = args.in[13]; const float* w_ba = args.in[14]; const float* w_out = args.in[15];
    const float* w_ff1 = args.in[16]; const float* w_ff2 = args.in[17];
    float* out = args.out;
    float* ADA = (float*)(ws + WS_ADA); float* LB = (float*)(ws + WS_LB); float* BT = (float*)(ws + WS_BT);
    bf16* WIN = (bf16*)(ws + WS_WIN); bf16* WBH = (bf16*)(ws + WS_WBH); bf16* WBA = (bf16*)(ws + WS_WBA); bf16* WOUT = (bf16*)(ws + WS_WOUT); bf16* WFF1 = (bf16*)(ws + WS_WFF1); bf16* WFF2 = (bf16*)(ws + WS_WFF2);
    unsigned char* ar = ws + WS_ARENA;
    bf16* QH = (bf16*)(ar + AO_QH); float* LOGF = (float*)(ar + AO_LOGF); bf16* VH = (bf16*)(ar + AO_VH); bf16* GH = (bf16*)(ar + AO_GH);
    bf16* AQ = (bf16*)(ar + AO_AQ); bf16* AK = (bf16*)(ar + AO_AK); bf16* VT = (bf16*)(ar + AO_VT); bf16* GSCR = (bf16*)(ar + AO_GSCR);
    bf16* MERGED = (bf16*)(ar + AO_MERGED); bf16* HB = (bf16*)(ar + AO_H); bf16* XN2 = (bf16*)(ar + AO_XN2); bf16* D1 = (bf16*)(ar + AO_D1);
    bf16* XN = (bf16*)(ar + AO_XN); bf16* OHG = (bf16*)out; bf16* OAT = (bf16*)((char*)out + 4 * MiB); bf16* QC = (bf16*)((char*)out + 8 * MiB); bf16* OLOC = (bf16*)((char*)out + 12 * MiB);
    float* SLOC = (float*)(ar + AO_SLOC); float* BSEG = (float*)(ar + AO_BSEG);
    const int gw = vcu * NWAVES + wave, NGW = G * NWAVES;

    bool split6 = false; unsigned tok6 = ~0u;
    if (IN(0)) REP(0) {
        if (bx < 192) p0_ada(lds, c, w_ada, b_ada, ADA, bx, tid);
        else if (bx == 192) {
            float l0v[2], l1v[2], rbv[4];
#pragma unroll
            for (int q = 0; q < 2; ++q) { const int i = tid + 512 * q; l0v[q] = lb_logits[i]; l1v[q] = lb_logits[1024 + i]; }
#pragma unroll
            for (int q = 0; q < 4; ++q) { const int i = tid + 512 * q, h = i >> 7, n = i & 127;
                int bkt = n; if (n >= 16) { bkt = 16 + (int)(logf((float)n / 16.0f) / logf(8.0f) * 16.0f); bkt = bkt > 31 ? 31 : bkt; }
                rbv[q] = rel_bias[bkt * 16 + h]; }
#pragma unroll
            for (int q = 0; q < 2; ++q) LB[tid + 512 * q] = 1.0f / (1.0f + expf(l1v[q] - l0v[q]));
#pragma unroll
            for (int q = 0; q < 4; ++q) BT[tid + 512 * q] = rbv[q];
        }
        LAS float* scr = (LAS float*)(lds + wave * P0_SCR);
        constexpr int I_IN = (DM / 64) * (INW / 64);
        const DescWin dw{w_in, WIN};
        if (bx < 192) transpose_items(dw, (bx * NWAVES + wave) * 2, 1, (bx * NWAVES + wave) * 2 + 2, scr, lane);
        else transpose_items(dw, 3072 + (bx - 192) * NWAVES + wave, 512, I_IN, scr, lane);
        SEAM(0);
    }
    if (IN(1)) REP(1) {
        norm_rows<false>(lds, x, (const bf16*)nullptr, norm1_g, ADA + 0 * DM, ADA + 1 * DM, lay::boff(XN, (size_t)(bx & 7) * lay::X8), bx, wave, lane, pg8n::NoHookN());
        SEAM(1);
    }
    if (IN(2)) REP(2) {
        pg8::Gemm g{XN, XN, WIN, WIN, DM, lay::X8, lay::X8}; pg8::StaticOrder S; S.init(M, INW - 2 * DM, G, bx, P2_WGM, true);
        pg8::EpiProj E{QH, VH, GH, AQ, AK, VT, GSCR, GSCR, LOGF, LB, lds + VT_TSC_OFF};
        pg8::gemm_phase<pg8::EpiProj, pg8::StaticOrder, GEMM_ALIGN, GEMM_SP2>(lds + RING_OFF, g, S, E);
        if (bx >= 128) {
            LAS float* scr = (LAS float*)(lds + wave * P0_SCR);
            const DescRest dr{w_bh, w_ba, w_out, w_ff1, w_ff2, WBH, WBA, WOUT, WFF1, WFF2};
            transpose_items(dr, (bx - 128) * NWAVES + wave, 128 * NWAVES, DescRest::NITEMS, scr, lane);
        }
        SEAM(2);
    }
    const int xb = bx & 7, xi = bx >> 3;
    if (IN(3)) REP(3) {
        const size_t xbs = (size_t)xb;
        hg::hgrn_seg(lds, xb * 8 + (xi >> 2), xi & 3, lay::boff(QH, xbs * lay::X4), lay::boff(LOGF, xbs * lay::X8), lay::boff(VH, xbs * lay::X4), lay::boff(OLOC, xbs * lay::D4), lay::boff(QC, xbs * lay::D4), lay::boff(SLOC, xbs * lay::X2), lay::boff(BSEG, xbs * lay::XB));
        const bool split3 = BOTH(3) && REP_MASK == 0 && MK_N_LAUNCHES != N_PHASES && ((LOCAL_SEAMS >> 3) & 1) && canon == 1;
        unsigned tok3 = ~0u;
        if (split3) tok3 = xcd_barrier_local_arrive(bar);
        for (int e = 0; e < 2; ++e) at::attn_unit(lds, xb * 64 + xi * 2 + e, lay::boff(AQ, xbs * lay::X4), lay::boff(AK, xbs * lay::X1), lay::boff(VT, xbs * lay::X1), lay::boff(OAT, xbs * lay::D4), q_norm_g, k_norm_g, sinks, e == 0 ? BT : nullptr);
        if (split3) xcd_barrier_local_wait(bar, tok3); else SEAM(3);
    }
    if (IN(4)) REP(4) {
        const size_t xbs = (size_t)xb;
        hg::hgrn_fix(lds, xb * 8 + (xi >> 2), xi & 3, lay::boff(OLOC, xbs * lay::D4), lay::boff(QC, xbs * lay::D4), lay::boff(SLOC, xbs * lay::X2), lay::boff(BSEG, xbs * lay::XB), lay::boff(GH, xbs * lay::X4), hg_out_g, lay::boff(OHG, xbs * lay::D4));
        SEAM(4);
    }
    if (IN(5)) REP(5) {
        pg8::Gemm4 g{XN, OHG, OAT, WIN + (size_t)22 * 256 * DM, WIN + (size_t)30 * 256 * DM, WBH, WBA, DM, HGW, lay::X8, lay::D4, lay::D4};
        pg8::QuadOrder S; S.b.init(M, DM, G, bx, P56_WGM);
        pg8::EpiMerge4 E{lay::boff(GSCR, (size_t)xb * lay::AR + (size_t)xi * 262144), MERGED};
        pg8::gemm_phase<pg8::EpiMerge4, pg8::QuadOrder, GEMM_ALIGN, GEMM_SP2, true, true, pg8::Gemm4>(lds + RING_OFF, g, S, E);
        SEAM(5);
    }
    if (IN(6)) REP(6) {
        pg8::Gemm g{MERGED, MERGED, WOUT, WOUT, DM, lay::X8, lay::X8}; pg8::StaticOrder S; S.init(M, DM, G, bx, P56_WGM);
        pg8::EpiDelta E{D1, ADA + 2 * DM, 12288};
        pg8::gemm_phase<pg8::EpiDelta, pg8::StaticOrder, GEMM_ALIGN, GEMM_SP2>(lds + RING_OFF, g, S, E);
        split6 = BOTH(6) && REP_MASK == 0 && MK_N_LAUNCHES != N_PHASES && ((LOCAL_SEAMS >> 6) & 1) && canon == 1;
        if (split6) tok6 = xcd_barrier_local_arrive(bar); else SEAM(6);
    }
    if (IN(7)) REP(7) {
        auto wait6 = [&]() __attribute__((always_inline)) { if (split6) xcd_barrier_local_wait(bar, tok6); };
        norm_rows<true>(lds, x, lay::boff(D1, (size_t)(bx & 7) * lay::X8), norm2_g, ADA + 3 * DM, ADA + 4 * DM, lay::boff(XN2, (size_t)(bx & 7) * lay::X8), bx, wave, lane, wait6);
        SEAM(7);
    }
    if (IN(8)) REP(8) {
        pg8::Gemm g{XN2, XN2, WFF1, WFF1, DM, lay::X8, lay::X8}; pg8::StaticOrder S; S.init(M, DFF, G, bx, P8_WGM);
        pg8::EpiRelu2 E{HB, DFF};
        pg8::gemm_phase<pg8::EpiRelu2, pg8::StaticOrder, GEMM_ALIGN, GEMM_SP2>(lds + RING_OFF, g, S, E);
        SEAM(8);
    }
    if (IN(9)) {
        pg8::Gemm g{HB, HB, WFF2, WFF2, DFF, lay::X32, lay::X32}; pg8::StaticOrder S; S.init(M, DM, G, bx, P9_WGM);
        pg8::EpiResGate E{x, D1, out, ADA + 5 * DM, 12288};
        pg8::gemm_phase<pg8::EpiResGate, pg8::StaticOrder, GEMM_ALIGN, GEMM_SP2>(lds + RING_OFF, g, S, E);
    }
#undef IN
#undef BOTH
#undef GRID_BAR
#undef GRID_BAR_FULL
}

extern "C" void kernel_launch(void* const* d_in, const int* in_sizes, int n_in, void* d_out, int out_size, void* d_ws, size_t ws_size, hipStream_t stream) {
    static int grid = 0;
    if (grid == 0) {
        if (n_in != 18 || out_size != M * DM || ws_size < WS_END) { fprintf(stderr, "kernel_launch: unexpected shapes (n_in %d, out %d, ws %zu)\n", n_in, out_size, ws_size); grid = -1; return; }
        int dev = 0, cus = 0, per_cu = 0;
        if (hipGetDevice(&dev) != hipSuccess || hipDeviceGetAttribute(&cus, hipDeviceAttributeMultiprocessorCount, dev) != hipSuccess) { grid = -1; return; }
        if (hipFuncSetAttribute((const void*)hyb_fwd, hipFuncAttributeMaxDynamicSharedMemorySize, LDS_BYTES) != hipSuccess) { fprintf(stderr, "kernel_launch: hipFuncSetAttribute failed\n"); grid = -1; return; }
        if (hipOccupancyMaxActiveBlocksPerMultiprocessor(&per_cu, (const void*)hyb_fwd, NWAVES * 64, LDS_BYTES) != hipSuccess || per_cu < 1) { fprintf(stderr, "kernel_launch: occupancy query says %d\n", per_cu); per_cu = 1; }
        (void)hipGetLastError();
        if (cus < 256) { fprintf(stderr, "kernel_launch: %d CUs: this kernel needs 256 co-resident workgroups (one per CU); nothing launched\n", cus); grid = -1; return; }
        grid = 256;
    }
    if (grid < 0) return;
    (void)hipMemsetAsync((char*)d_ws + WS_CTL, 0, CTL_ZERO_BYTES, stream);
    Args a{};
    for (int i = 0; i < 18; ++i) a.in[i] = (const float*)d_in[i];
    a.out = (float*)d_out; a.ws = (unsigned char*)d_ws;
#ifndef PROBE_PHASE
#define PROBE_PHASE -1
#endif
    if (PROBE_PHASE >= 0) {
        a.ph_lo = 0; a.ph_hi = PROBE_PHASE + 1; a.li = 0;
        hipLaunchKernelGGL(hyb_fwd, dim3(grid), dim3(NWAVES * 64), LDS_BYTES, stream, a);
        a.ph_lo = PROBE_PHASE; a.ph_hi = N_PHASES; a.li = 1;
        hipLaunchKernelGGL(hyb_fwd, dim3(grid), dim3(NWAVES * 64), LDS_BYTES, stream, a);
    } else if (MK_N_LAUNCHES == 1) {
        a.ph_lo = 0; a.ph_hi = N_PHASES; a.li = 0;
        hipLaunchKernelGGL(hyb_fwd, dim3(grid), dim3(NWAVES * 64), LDS_BYTES, stream, a);
    } else {
        for (int li = 0; li < N_PHASES; ++li) { a.ph_lo = li; a.ph_hi = li + 1; a.li = 0;
            hipLaunchKernelGGL(hyb_fwd, dim3(grid), dim3(NWAVES * 64), LDS_BYTES, stream, a); }
    }
}
```
